# Optimizing an MI355X kernel written in HIP

```python
import math
import jax, jax.numpy as jnp
from jax import lax
import numpy as np

D_MODEL = 1024
BATCH = 8
SEQ = 2048
DEPTH = 2

HEAD_DIM = 64
MEM_HEADS = 4
MEM_WIDTH = MEM_HEADS * HEAD_DIM
SB_HEADS = (D_MODEL - MEM_WIDTH) // (2 * HEAD_DIM)
MOBA_HEADS = SB_HEADS
SB_WIDTH = SB_HEADS * HEAD_DIM
MOBA_WIDTH = MOBA_HEADS * HEAD_DIM
MIX_WIDTH = SB_WIDTH + MOBA_WIDTH + MEM_WIDTH
IN_COLS = 4 * SB_WIDTH + 4 * MOBA_WIDTH + 2 * MEM_WIDTH
MEM_LEN = 256
SB_BLOCK = 128
MOBA_BLOCK = 256
MOBA_TOPK = 3
MOBA_Q_CHUNK = 64
ROPE_THETA = 500000.0
ROPE_DIMS = HEAD_DIM // 4
NORM_EPS = 1e-6
NEG_INF = -1e30

kernel_name = "hybrid_stickbreak_moba_memxattn"


def rms_norm(x, g):
    xf = x.astype(jnp.float32)
    y = xf * lax.rsqrt(jnp.mean(xf * xf, axis=-1, keepdims=True) + NORM_EPS)
    return (y * g.astype(jnp.float32)).astype(x.dtype)


def split_heads(t, n_heads):
    b, s, _ = t.shape
    return t.reshape(b, s, n_heads, HEAD_DIM).transpose(0, 2, 1, 3)


def merge_heads(t):
    b, h, s, d = t.shape
    return t.transpose(0, 2, 1, 3).reshape(b, s, h * d)


def partial_rotary(t, pos):
    half = ROPE_DIMS // 2
    inv_freq = jnp.float32(ROPE_THETA) ** (-jnp.arange(half, dtype=jnp.float32) * 2.0 / ROPE_DIMS)
    ang = pos.astype(jnp.float32)[:, None] * inv_freq[None, :]
    cos, sin = jnp.cos(ang), jnp.sin(ang)
    tf = t.astype(jnp.float32)
    x1, x2, rest = tf[..., :half], tf[..., half:ROPE_DIMS], tf[..., ROPE_DIMS:]
    out = jnp.concatenate([x1 * cos - x2 * sin, x2 * cos + x1 * sin, rest], axis=-1)
    return out.astype(t.dtype)


def stick_breaking_attention(q, k, v):
    T = q.shape[2]
    scale = HEAD_DIM ** -0.5
    outs = []
    for i in range(T // SB_BLOCK):
        q0, q1 = i * SB_BLOCK, (i + 1) * SB_BLOCK
        qb = q[:, :, q0:q1]
        kb, vb = k[:, :, :q1], v[:, :, :q1]
        z = jnp.einsum('bhqd,bhkd->bhqk', qb, kb, preferred_element_type=jnp.float32) * scale
        past = jnp.arange(q1)[None, :] < jnp.arange(q0, q1)[:, None]
        log_beta = jax.nn.log_sigmoid(z)
        log_one_minus = jnp.where(past, log_beta - z, 0.0)
        later = lax.cumsum(log_one_minus, axis=3, reverse=True) - log_one_minus
        w = jnp.where(past, jnp.exp(log_beta + later), 0.0)
        outs.append(jnp.einsum('bhqk,bhkd->bhqd', w.astype(v.dtype), vb))
    return jnp.concatenate(outs, axis=2)


def moba_attention(q, k, v):
    B, H, T, dh = q.shape
    n_blk = -(-T // MOBA_BLOCK)
    Tp = n_blk * MOBA_BLOCK
    pad = [(0, 0), (0, 0), (0, Tp - T), (0, 0)]
    kp, vp = jnp.pad(k, pad), jnp.pad(v, pad)
    kblk = kp.reshape(B, H, n_blk, MOBA_BLOCK, dh)
    vblk = vp.reshape(B, H, n_blk, MOBA_BLOCK, dh)
    kmean = jnp.mean(kblk.astype(jnp.float32), axis=3)
    topk = min(MOBA_TOPK, n_blk - 1)
    scale = dh ** -0.5
    bi = jnp.arange(B)[:, None, None, None]
    hi = jnp.arange(H)[None, :, None, None]

    def chunk(ci):
        c0 = ci * MOBA_Q_CHUNK
        qc = lax.dynamic_slice_in_dim(q, c0, MOBA_Q_CHUNK, axis=2)
        t_pos = c0 + jnp.arange(MOBA_Q_CHUNK)
        own = c0 // MOBA_BLOCK
        own_start = own * MOBA_BLOCK
        k_own = lax.dynamic_slice_in_dim(kp, own_start, MOBA_BLOCK, axis=2)
        v_own = lax.dynamic_slice_in_dim(vp, own_start, MOBA_BLOCK, axis=2)
        s_own = jnp.einsum('bhqd,bhkd->bhqk', qc, k_own, preferred_element_type=jnp.float32) * scale
        causal = (own_start + jnp.arange(MOBA_BLOCK))[None, :] <= t_pos[:, None]
        s_own = jnp.where(causal, s_own, NEG_INF)
        if topk > 0:
            gate = jnp.einsum('bhqd,bhnd->bhqn', qc.astype(jnp.float32), kmean)
            gate = jnp.where(jnp.arange(n_blk) < own, gate, -jnp.inf)
            _, sel = lax.top_k(gate, topk)
            sel_valid = sel < own
            k_sel = kblk[bi, hi, sel]
            v_sel = vblk[bi, hi, sel]
            s_sel = jnp.einsum('bhqd,bhqnkd->bhqnk', qc, k_sel, preferred_element_type=jnp.float32) * scale
            s_sel = jnp.where(sel_valid[..., None], s_sel, NEG_INF)
            s_sel = s_sel.reshape(B, H, MOBA_Q_CHUNK, topk * MOBA_BLOCK)
            p = jax.nn.softmax(jnp.concatenate([s_sel, s_own], axis=-1), axis=-1)
            p_sel = p[..., :topk * MOBA_BLOCK].reshape(B, H, MOBA_Q_CHUNK, topk, MOBA_BLOCK)
            p_own = p[..., topk * MOBA_BLOCK:]
            o = (jnp.einsum('bhqnk,bhqnkd->bhqd', p_sel.astype(v.dtype), v_sel)
                 + jnp.einsum('bhqk,bhkd->bhqd', p_own.astype(v.dtype), v_own))
        else:
            p_own = jax.nn.softmax(s_own, axis=-1)
            o = jnp.einsum('bhqk,bhkd->bhqd', p_own.astype(v.dtype), v_own)
        return o

    outs = lax.map(chunk, jnp.arange(T // MOBA_Q_CHUNK))
    return outs.transpose(1, 2, 0, 3, 4).reshape(B, H, T, dh)


def memory_attention(q, mk, mv):
    s = jnp.einsum('bhqd,bhmd->bhqm', q, mk, preferred_element_type=jnp.float32) * (HEAD_DIM ** -0.5)
    p = jax.nn.softmax(s, axis=-1)
    return jnp.einsum('bhqm,bhmd->bhqd', p.astype(mv.dtype), mv)


def setup_inputs(seed: int = 0) -> dict:
    key = jax.random.key(seed)
    ks = jax.random.split(key, 8)
    x = jax.random.normal(ks[0], (BATCH, SEQ, D_MODEL), jnp.float32)
    mem = jax.random.normal(ks[1], (BATCH, MEM_LEN, D_MODEL), jnp.float32)
    norm_g = 1.0 + 0.02 * jax.random.normal(ks[2], (DEPTH, D_MODEL), jnp.float32)
    w_in = jax.random.normal(ks[3], (DEPTH, D_MODEL, IN_COLS), jnp.float32) * D_MODEL ** -0.5
    mem_norm_g = 1.0 + 0.02 * jax.random.normal(ks[4], (DEPTH, D_MODEL), jnp.float32)
    w_mem_kv = jax.random.normal(ks[5], (DEPTH, D_MODEL, 2 * MEM_WIDTH), jnp.float32) * D_MODEL ** -0.5
    w_out = jax.random.normal(ks[6], (DEPTH, MIX_WIDTH, D_MODEL), jnp.float32) * MIX_WIDTH ** -0.5
    final_norm_g = 1.0 + 0.02 * jax.random.normal(ks[7], (D_MODEL,), jnp.float32)
    return {"x": x, "mem": mem, "norm_g": norm_g, "w_in": w_in, "mem_norm_g": mem_norm_g,
            "w_mem_kv": w_mem_kv, "w_out": w_out, "final_norm_g": final_norm_g}


def reference(x, mem, norm_g, w_in, mem_norm_g, w_mem_kv, w_out, final_norm_g):
    T = x.shape[1]
    pos = jnp.arange(T)
    widths = [SB_WIDTH] * 4 + [MOBA_WIDTH] * 4 + [MEM_WIDTH] * 2
    split_at = np.cumsum(widths)[:-1].tolist()
    for layer in range(DEPTH):
        h = rms_norm(x, norm_g[layer])
        proj = jnp.einsum('btd,dc->btc', h, w_in[layer])
        sb_q, sb_k, sb_v, sb_g, mb_q, mb_k, mb_v, mb_g, mem_q, mem_g = jnp.split(proj, split_at, axis=-1)

        o_sb = stick_breaking_attention(split_heads(sb_q, SB_HEADS), split_heads(sb_k, SB_HEADS),
                                        split_heads(sb_v, SB_HEADS))
        o_sb = merge_heads(o_sb) * jax.nn.silu(sb_g)

        q_mb = partial_rotary(split_heads(mb_q, MOBA_HEADS), pos)
        k_mb = partial_rotary(split_heads(mb_k, MOBA_HEADS), pos)
        o_mb = moba_attention(q_mb, k_mb, split_heads(mb_v, MOBA_HEADS))
        o_mb = merge_heads(o_mb) * jax.nn.silu(mb_g)

        m = rms_norm(mem, mem_norm_g[layer])
        mkv = jnp.einsum('bmd,dc->bmc', m, w_mem_kv[layer])
        mk, mv = jnp.split(mkv, 2, axis=-1)
        o_mem = memory_attention(split_heads(mem_q, MEM_HEADS), split_heads(mk, MEM_HEADS),
                                 split_heads(mv, MEM_HEADS))
        o_mem = merge_heads(o_mem) * jax.nn.silu(mem_g)

        mixed = jnp.concatenate([o_sb, o_mb, o_mem], axis=-1)
        x = x + jnp.einsum('btc,cd->btd', mixed, w_out[layer])
    return rms_norm(x, final_norm_g)
```

```cpp
#include <hip/hip_runtime.h>
#include <hip/hip_cooperative_groups.h>
#include <stdint.h>
#include <cstdio>
namespace cg = cooperative_groups;

#ifndef MULTI_LAUNCH
#define MULTI_LAUNCH 0
#endif
#ifndef NAIVE_ATTN
#define NAIVE_ATTN 0
#endif

typedef unsigned short bf16_t;
using bf16x8 = __attribute__((ext_vector_type(8))) short;
using f32x4 = __attribute__((ext_vector_type(4))) float;
using u32x4 = __attribute__((ext_vector_type(4))) unsigned;
#define DI __device__ __forceinline__

constexpr int NB = 8, T = 2048, D = 1024, NTOK = NB * T, INC = 3584, MEML = 256, NMEM = NB * MEML;
constexpr int C_SBQ = 0, C_SBK = 384, C_SBV = 768, C_SBG = 1152, C_MBQ = 1536, C_MBK = 1920, C_MBV = 2304, C_MBG = 2688,
              C_MQ = 3072, C_MG = 3328;

struct Params {
  const float* x; const float* mem; const float* norm_g; const float* w_in; const float* mem_norm_g;
  const float* w_mem_kv; const float* w_out; const float* final_g;
  float* out;
  bf16_t* xb; bf16_t* proj; bf16_t* mixed; bf16_t* wTin; bf16_t* wTkv; bf16_t* wTout; bf16_t* memb; bf16_t* mkv;
  float* ss; float* memss; float* kmean; float* costab; float* sintab;
  bf16_t* sbvT; bf16_t* mbvT; bf16_t* mvT;
  unsigned* bar;
};

DI bf16_t f2bf(float x) { unsigned u = __float_as_uint(x); u += 0x7fffu + ((u >> 16) & 1u); return (bf16_t)(u >> 16); }
DI float bf2f(bf16_t b) { return __uint_as_float(((unsigned)b) << 16); }
DI float bflo(unsigned u) { return __uint_as_float(u << 16); }
DI float bfhi(unsigned u) { return __uint_as_float(u & 0xffff0000u); }
typedef float f32x2_t __attribute__((ext_vector_type(2)));
typedef __bf16 bf16x2_t __attribute__((ext_vector_type(2)));
DI unsigned pack2(float a, float b) { f32x2_t v = {a, b}; return __builtin_bit_cast(unsigned, __builtin_convertvector(v, bf16x2_t)); }
DI float shfl16(float x) {
  const unsigned u = __float_as_uint(x);
  auto r = __builtin_amdgcn_permlane16_swap(u, u, false, false);
  return __uint_as_float((r[0] == u) ? r[1] : r[0]);
}
DI float shfl32(float x) {
  const unsigned u = __float_as_uint(x);
  auto r = __builtin_amdgcn_permlane32_swap(u, u, false, false);
  return __uint_as_float((r[0] == u) ? r[1] : r[0]);
}
DI float wave_sum(float v) {
#pragma unroll
  for (int o = 32; o >= 1; o >>= 1) v += __shfl_xor(v, o);
  return v;
}

DI void transpose_tile(const float* __restrict__ src, const float* __restrict__ g, bf16_t* __restrict__ dst, int N, int kt, int nt,
                       float* tile, int g_tid) {
  const int tid = g_tid;
  __syncthreads();
#pragma unroll
  for (int pss = 0; pss < 4; ++pss) {
    int kr = pss * 16 + (tid >> 4), nc = (tid & 15) * 4;
    int k = kt * 64 + kr;
    float4 v = *(const float4*)(src + (size_t)k * N + nt * 64 + nc);
    float gs = g ? g[k] : 1.f;
    tile[kr * 65 + nc + 0] = v.x * gs; tile[kr * 65 + nc + 1] = v.y * gs;
    tile[kr * 65 + nc + 2] = v.z * gs; tile[kr * 65 + nc + 3] = v.w * gs;
  }
  __syncthreads();
#pragma unroll
  for (int pss = 0; pss < 2; ++pss) {
    int nr = pss * 32 + (tid >> 3), kc = (tid & 7) * 8;
    uint4 o;
    o.x = pack2(tile[(kc + 0) * 65 + nr], tile[(kc + 1) * 65 + nr]);
    o.y = pack2(tile[(kc + 2) * 65 + nr], tile[(kc + 3) * 65 + nr]);
    o.z = pack2(tile[(kc + 4) * 65 + nr], tile[(kc + 5) * 65 + nr]);
    o.w = pack2(tile[(kc + 6) * 65 + nr], tile[(kc + 7) * 65 + nr]);
    *(uint4*)(dst + (size_t)(nt * 64 + nr) * 1024 + kt * 64 + kc) = o;
  }
}

DI void row_convert(const float* __restrict__ src, bf16_t* __restrict__ dst, float* __restrict__ ssout, int row, int lane) {
  const float* r = src + (size_t)row * 1024;
  float s = 0.f;
#pragma unroll
  for (int i = 0; i < 2; ++i) {
    int c = i * 512 + lane * 8;
    float4 a = *(const float4*)(r + c), b = *(const float4*)(r + c + 4);
    s += a.x * a.x + a.y * a.y + a.z * a.z + a.w * a.w + b.x * b.x + b.y * b.y + b.z * b.z + b.w * b.w;
    uint4 o; o.x = pack2(a.x, a.y); o.y = pack2(a.z, a.w); o.z = pack2(b.x, b.y); o.w = pack2(b.z, b.w);
    *(uint4*)(dst + (size_t)row * 1024 + c) = o;
  }
  s = wave_sum(s);
  if (lane == 0) ssout[row] = s;
}

DI void phase_prepass(const Params& p, char* smem, int g_tid, int g_bid) {
  const int tid = g_tid, lane = tid & 63, wid = tid >> 6;
  const int gtid = g_bid * 256 + tid, gth = gridDim.x * 256;
  for (int i = gtid; i < 2 * 8 * 8 * 384; i += gth) p.kmean[i] = 0.f;
  for (int i = gtid; i < 2 * NTOK; i += gth) p.ss[NTOK + i] = 0.f;
  for (int i = gtid; i < T * 8; i += gth) {
    int pos = i >> 3, f = i & 7;
    const float invf[8] = {1.000000000e+00f, 1.939227447e-01f, 3.760603093e-02f, 7.292664737e-03f, 1.414213562e-03f, 2.742481757e-04f, 5.318295897e-05f, 1.031338538e-05f};
    float inv = invf[0];
#pragma unroll
    for (int q = 1; q < 8; ++q) inv = (f == q) ? invf[q] : inv;
    float ang = (float)pos * inv;
    p.costab[i] = cosf(ang); p.sintab[i] = sinf(ang);
  }
  const int NT_IN = 16 * 56, NT_KV = 16 * 8, NT_OUT = 16 * 16;
  const int per_layer = NT_IN + NT_KV + NT_OUT;
  for (int job = g_bid; job < 2 * per_layer; job += gridDim.x) {
    int layer = job / per_layer, j = job % per_layer;
    if (j < NT_IN) {
      transpose_tile(p.w_in + (size_t)layer * 1024 * INC, p.norm_g + layer * 1024, p.wTin + (size_t)layer * INC * 1024, INC, j / 56, j % 56,
                     (float*)smem, g_tid);
    } else if (j < NT_IN + NT_KV) {
      j -= NT_IN;
      transpose_tile(p.w_mem_kv + (size_t)layer * 1024 * 512, p.mem_norm_g + layer * 1024, p.wTkv + (size_t)layer * 512 * 1024, 512, j / 8,
                     j % 8, (float*)smem, g_tid);
    } else {
      j -= NT_IN + NT_KV;
      transpose_tile(p.w_out + (size_t)layer * 1024 * 1024, nullptr, p.wTout + (size_t)layer * 1024 * 1024, 1024, j / 16, j % 16,
                     (float*)smem, g_tid);
    }
  }
  {
    const int stride = gridDim.x * 4;
    for (int r0 = g_bid * 4 + wid; r0 < NTOK + NMEM; r0 += 3 * stride) {
      float4 va[3][4];
#pragma unroll
      for (int u = 0; u < 3; ++u) {
        const int r = r0 + u * stride;
        if (r < NTOK + NMEM) {
          const float* rp = (r < NTOK) ? p.x + (size_t)r * 1024 : p.mem + (size_t)(r - NTOK) * 1024;
#pragma unroll
          for (int i = 0; i < 2; ++i) { va[u][2 * i] = *(const float4*)(rp + i * 512 + lane * 8); va[u][2 * i + 1] = *(const float4*)(rp + i * 512 + lane * 8 + 4); }
        }
      }
#pragma unroll
      for (int u = 0; u < 3; ++u) {
        const int r = r0 + u * stride;
        if (r < NTOK + NMEM) {
          bf16_t* dp = (r < NTOK) ? p.xb + (size_t)r * 1024 : p.memb + (size_t)(r - NTOK) * 1024;
          float sacc = 0.f;
#pragma unroll
          for (int i = 0; i < 2; ++i) {
            const float4 a = va[u][2 * i], b = va[u][2 * i + 1];
            sacc += a.x * a.x + a.y * a.y + a.z * a.z + a.w * a.w + b.x * b.x + b.y * b.y + b.z * b.z + b.w * b.w;
            uint4 o; o.x = pack2(a.x, a.y); o.y = pack2(a.z, a.w); o.z = pack2(b.x, b.y); o.w = pack2(b.z, b.w);
            *(uint4*)(dp + i * 512 + lane * 8) = o;
          }
          sacc = wave_sum(sacc);
          if (lane == 0) { if (r < NTOK) p.ss[r] = sacc; else p.memss[r - NTOK] = sacc; }
        }
      }
    }
  }
}

constexpr int LDS_STR = 72;
constexpr int G_STAGE = (256 + 128) * 64;

template <int MODE, int MT>
DI void gemm_tile(const Params& p, int layer, int mt, int nt, char* smem, int g_tid) {
  const int tid = g_tid, lane = tid & 63, wid = tid >> 6, wr = wid >> 1, wc = wid & 1;
  const int fr = lane & 15, fq = lane >> 4;
  const bf16_t* A; const bf16_t* Bt;
  if (MODE == 0) { A = p.xb; Bt = p.wTin + (size_t)layer * INC * 1024; }
  else if (MODE == 1) { A = p.memb; Bt = p.wTkv + (size_t)layer * 512 * 1024; }
  else { A = p.mixed; Bt = p.wTout + (size_t)layer * 1024 * 1024; }
  const bf16_t* Ag = A + (size_t)(mt * (MT * 32)) * 1024;
  const bf16_t* Bg = Bt + (size_t)(nt * 128) * 1024;
  f32x4 acc[MT][4];
#pragma unroll
  for (int m = 0; m < MT; ++m)
#pragma unroll
    for (int n = 0; n < 4; ++n) acc[m][n] = f32x4{0.f, 0.f, 0.f, 0.f};
  constexpr int NLD = (MT == 8) ? 6 : 4;
  u32x4 rgA[NLD], rgB[NLD];
  const unsigned goff0 = (unsigned)((tid >> 2) * 2048 + (((tid & 3) ^ (((tid >> 5) & 1) * 3)) * 16));
  const int sbase = tid * 16;
  const char* Ab = (const char*)Ag; const char* Bb = (const char*)Bg;
#define G_LOAD(R, KT) _Pragma("unroll") for (int i = 0; i < NLD; ++i) { \
    const int ii = (MT == 8) ? i : (i < 2 ? i : i + 2); \
    const char* gb = ((ii < 4) ? Ab + ii * 131072 : Bb + (ii - 4) * 131072) + (KT) * 64; \
    R[i] = *(const u32x4*)(gb + goff0); }
#define G_STORE(R, ST) _Pragma("unroll") for (int i = 0; i < NLD; ++i) { \
    const int ii = (MT == 8) ? i : (i < 2 ? i : i + 2); \
    *(u32x4*)((ST) + ii * 4096 + sbase) = R[i]; }
#define G_COMPUTE(ST) { const char* st = (ST); bf16x8 b[4]; \
    _Pragma("unroll") for (int n = 0; n < 4; ++n) b[n] = *(const bf16x8*)(st + boff + (n >> 1) * 2048 + (n & 1) * 256); \
    _Pragma("unroll") for (int mh = 0; mh < MT; mh += 4) { bf16x8 a[4]; \
      _Pragma("unroll") for (int m = 0; m < 4; ++m) a[m] = *(const bf16x8*)(st + aoff + (mh + m) * 1024); \
      __builtin_amdgcn_s_setprio(1); \
      _Pragma("unroll") for (int m = 0; m < 4; ++m) \
        _Pragma("unroll") for (int n = 0; n < 4; ++n) acc[mh + m][n] = __builtin_amdgcn_mfma_f32_16x16x32_bf16(b[n], a[m], acc[mh + m][n], 0, 0, 0); \
      __builtin_amdgcn_s_setprio(0); } }
  const int aoff = (wr * (MT * 16) + fr) * 64 + ((fq ^ (((fr >> 3) & 1) * 3)) & 3) * 16;
  const int boff = 16384 + (wc * 64 + 8 * (fr >> 2) + (fr & 3)) * 64 + ((fq ^ (((fr >> 2) & 1) * 3)) & 3) * 16;
  G_LOAD(rgA, 0)
  G_STORE(rgA, smem)
  G_LOAD(rgA, 1)
  G_LOAD(rgB, 2)
#pragma unroll 1
  for (int kt = 0; kt < 32; kt += 2) {
    __syncthreads();
    G_STORE(rgA, smem + G_STAGE)
    if (kt + 3 < 32) G_LOAD(rgA, kt + 3)
    G_COMPUTE(smem)
    __syncthreads();
    if (kt + 2 < 32) G_STORE(rgB, smem)
    if (kt + 4 < 32) G_LOAD(rgB, kt + 4)
    G_COMPUTE(smem + G_STAGE)
  }
#undef G_LOAD
#undef G_STORE
#undef G_COMPUTE
  const int cb = nt * 128 + wc * 64;
  const int rb0 = mt * (MT * 32) + wr * (MT * 16);
  if (MODE == 0) {
    const bool rot = (cb >= C_MBQ && cb < C_MBV);
    const bool km = (cb >= C_MBK && cb < C_MBV);
    f32x4 colsum[4];
#pragma unroll
    for (int n = 0; n < 4; ++n) colsum[n] = f32x4{0.f, 0.f, 0.f, 0.f};
    float rsv[MT];
#pragma unroll
    for (int m = 0; m < MT; ++m) rsv[m] = p.ss[layer * NTOK + rb0 + m * 16 + fr];
#pragma unroll
    for (int m = 0; m < MT; ++m) rsv[m] = rsqrtf(rsv[m] * (1.f / 1024.f) + 1e-6f);
#pragma unroll
    for (int m = 0; m < MT; ++m) {
      const int grow = rb0 + m * 16 + fr;
      const float rs = rsv[m];
#pragma unroll
      for (int pp = 0; pp < 2; ++pp) {
        f32x4 v0 = acc[m][2 * pp] * rs, v1 = acc[m][2 * pp + 1] * rs;
        if (pp == 0 && rot) {
          const int pos = grow & (T - 1);
          const float4 c0 = *(const float4*)(p.costab + pos * 8), c1 = *(const float4*)(p.costab + pos * 8 + 4);
          const float4 s0 = *(const float4*)(p.sintab + pos * 8), s1 = *(const float4*)(p.sintab + pos * 8 + 4);
          const float cc[8] = {c0.x, c0.y, c0.z, c0.w, c1.x, c1.y, c1.z, c1.w};
          const float sn[8] = {s0.x, s0.y, s0.z, s0.w, s1.x, s1.y, s1.z, s1.w};
#pragma unroll
          for (int j = 0; j < 4; ++j) {
            const float p0 = shfl16(v0[j]), p1 = shfl16(v1[j]);
            const float r0 = (fq == 0) ? (v0[j] * cc[j] - p0 * sn[j]) : (v0[j] * cc[j] + p0 * sn[j]);
            const float r1 = (fq == 0) ? (v1[j] * cc[4 + j] - p1 * sn[4 + j]) : (v1[j] * cc[4 + j] + p1 * sn[4 + j]);
            v0[j] = (fq < 2) ? r0 : v0[j];
            v1[j] = (fq < 2) ? r1 : v1[j];
          }
        }
        if (km) { colsum[2 * pp] += v0; colsum[2 * pp + 1] += v1; }
        uint4 o; o.x = pack2(v0[0], v0[1]); o.y = pack2(v0[2], v0[3]); o.z = pack2(v1[0], v1[1]); o.w = pack2(v1[2], v1[3]);
        *(uint4*)(p.proj + (size_t)grow * INC + cb + pp * 32 + fq * 8) = o;
      }
      if (m & 1) asm volatile("" ::: "memory");
    }
    if (km) {
      const int b = rb0 / T, blk = (rb0 % T) / 256;
#pragma unroll
      for (int n = 0; n < 4; ++n)
#pragma unroll
        for (int j = 0; j < 4; ++j) {
          float sm = colsum[n][j];
          sm += __shfl_xor(sm, 1); sm += __shfl_xor(sm, 2); sm += __shfl_xor(sm, 4); sm += __shfl_xor(sm, 8);
          if (fr == 0) atomicAdd(&p.kmean[((layer * 8 + b) * 8 + blk) * 384 + (cb - C_MBK) + (n >> 1) * 32 + fq * 8 + (n & 1) * 4 + j], sm);
        }
    }
  } else if (MODE == 1) {
    float rsv[MT];
#pragma unroll
    for (int m = 0; m < MT; ++m) rsv[m] = p.memss[rb0 + m * 16 + fr];
#pragma unroll
    for (int m = 0; m < MT; ++m) rsv[m] = rsqrtf(rsv[m] * (1.f / 1024.f) + 1e-6f);
#pragma unroll
    for (int m = 0; m < MT; ++m) {
      const int grow = rb0 + m * 16 + fr;
#pragma unroll
      for (int pp = 0; pp < 2; ++pp) {
        f32x4 v0 = acc[m][2 * pp] * rsv[m], v1 = acc[m][2 * pp + 1] * rsv[m];
        uint4 o; o.x = pack2(v0[0], v0[1]); o.y = pack2(v0[2], v0[3]); o.z = pack2(v1[0], v1[1]); o.w = pack2(v1[2], v1[3]);
        *(uint4*)(p.mkv + (size_t)layer * NMEM * 512 + (size_t)grow * 512 + cb + pp * 32 + fq * 8) = o;
      }
      if (m & 1) asm volatile("" ::: "memory");
    }
  } else {
    if (layer == 0) {
#pragma unroll
      for (int mp = 0; mp < MT / 2; ++mp) {
        uint4 xo[2][2];
#pragma unroll
        for (int h2 = 0; h2 < 2; ++h2)
#pragma unroll
          for (int pp = 0; pp < 2; ++pp)
            xo[h2][pp] = *(const uint4*)(p.xb + (size_t)(rb0 + (mp * 2 + h2) * 16 + fr) * 1024 + cb + pp * 32 + fq * 8);
#pragma unroll
        for (int h2 = 0; h2 < 2; ++h2) {
          const int m = mp * 2 + h2;
          const int grow = rb0 + m * 16 + fr;
          float sq = 0.f;
#pragma unroll
          for (int pp = 0; pp < 2; ++pp) {
            const size_t idx = (size_t)grow * 1024 + cb + pp * 32 + fq * 8;
            const uint4 u = xo[h2][pp];
            float4 xa, xc;
            xa.x = bflo(u.x) + acc[m][2 * pp][0]; xa.y = bfhi(u.x) + acc[m][2 * pp][1];
            xa.z = bflo(u.y) + acc[m][2 * pp][2]; xa.w = bfhi(u.y) + acc[m][2 * pp][3];
            xc.x = bflo(u.z) + acc[m][2 * pp + 1][0]; xc.y = bfhi(u.z) + acc[m][2 * pp + 1][1];
            xc.z = bflo(u.w) + acc[m][2 * pp + 1][2]; xc.w = bfhi(u.w) + acc[m][2 * pp + 1][3];
            uint4 o; o.x = pack2(xa.x, xa.y); o.y = pack2(xa.z, xa.w); o.z = pack2(xc.x, xc.y); o.w = pack2(xc.z, xc.w);
            *(uint4*)(p.xb + idx) = o;
            sq += xa.x * xa.x + xa.y * xa.y + xa.z * xa.z + xa.w * xa.w + xc.x * xc.x + xc.y * xc.y + xc.z * xc.z + xc.w * xc.w;
          }
          sq += shfl16(sq); sq += shfl32(sq);
          if (fq == 0) atomicAdd(&p.ss[NTOK + grow], sq);
        }
        asm volatile("" ::: "memory");
      }
    } else {
#pragma unroll
      for (int mp = 0; mp < MT / 2; ++mp) {
        uint4 xo[2][2];
#pragma unroll
        for (int h2 = 0; h2 < 2; ++h2)
#pragma unroll
          for (int pp = 0; pp < 2; ++pp)
            xo[h2][pp] = *(const uint4*)(p.xb + (size_t)(rb0 + (mp * 2 + h2) * 16 + fr) * 1024 + cb + pp * 32 + fq * 8);
#pragma unroll
        for (int h2 = 0; h2 < 2; ++h2) {
          const int m = mp * 2 + h2;
          const int grow = rb0 + m * 16 + fr;
          float sq = 0.f;
#pragma unroll
          for (int pp = 0; pp < 2; ++pp) {
            const size_t idx = (size_t)grow * 1024 + cb + pp * 32 + fq * 8;
            const uint4 u = xo[h2][pp];
            float4 xa, xc;
            xa.x = bflo(u.x) + acc[m][2 * pp][0]; xa.y = bfhi(u.x) + acc[m][2 * pp][1];
            xa.z = bflo(u.y) + acc[m][2 * pp][2]; xa.w = bfhi(u.y) + acc[m][2 * pp][3];
            xc.x = bflo(u.z) + acc[m][2 * pp + 1][0]; xc.y = bfhi(u.z) + acc[m][2 * pp + 1][1];
            xc.z = bflo(u.w) + acc[m][2 * pp + 1][2]; xc.w = bfhi(u.w) + acc[m][2 * pp + 1][3];
            { uint4 o; o.x = pack2(xa.x, xa.y); o.y = pack2(xa.z, xa.w); o.z = pack2(xc.x, xc.y); o.w = pack2(xc.z, xc.w);
              *(uint4*)(p.xb + idx) = o; }
            sq += xa.x * xa.x + xa.y * xa.y + xa.z * xa.z + xa.w * xa.w + xc.x * xc.x + xc.y * xc.y + xc.z * xc.z + xc.w * xc.w;
          }
          sq += shfl16(sq); sq += shfl32(sq);
          if (fq == 0) atomicAdd(&p.ss[2 * NTOK + grow], sq);
        }
        asm volatile("" ::: "memory");
      }
    }
  }
}

DI void load_row64(const bf16_t* __restrict__ ptr, float (&r)[64], float scale) {
#pragma unroll
  for (int i = 0; i < 8; ++i) {
    uint4 u = *(const uint4*)(ptr + i * 8);
    r[i * 8 + 0] = bflo(u.x) * scale; r[i * 8 + 1] = bfhi(u.x) * scale;
    r[i * 8 + 2] = bflo(u.y) * scale; r[i * 8 + 3] = bfhi(u.y) * scale;
    r[i * 8 + 4] = bflo(u.z) * scale; r[i * 8 + 5] = bfhi(u.z) * scale;
    r[i * 8 + 6] = bflo(u.w) * scale; r[i * 8 + 7] = bfhi(u.w) * scale;
  }
}
DI float dot_row64(const bf16_t* __restrict__ ptr, const float (&q)[64]) {
  float z = 0.f;
#pragma unroll
  for (int i = 0; i < 8; ++i) {
    uint4 u = *(const uint4*)(ptr + i * 8);
    z += q[i * 8 + 0] * bflo(u.x); z += q[i * 8 + 1] * bfhi(u.x);
    z += q[i * 8 + 2] * bflo(u.y); z += q[i * 8 + 3] * bfhi(u.y);
    z += q[i * 8 + 4] * bflo(u.z); z += q[i * 8 + 5] * bfhi(u.z);
    z += q[i * 8 + 6] * bflo(u.w); z += q[i * 8 + 7] * bfhi(u.w);
  }
  return z;
}
DI void axpy_row64(const bf16_t* __restrict__ ptr, float w, float (&acc)[64]) {
#pragma unroll
  for (int i = 0; i < 8; ++i) {
    uint4 u = *(const uint4*)(ptr + i * 8);
    acc[i * 8 + 0] += w * bflo(u.x); acc[i * 8 + 1] += w * bfhi(u.x);
    acc[i * 8 + 2] += w * bflo(u.y); acc[i * 8 + 3] += w * bfhi(u.y);
    acc[i * 8 + 4] += w * bflo(u.z); acc[i * 8 + 5] += w * bfhi(u.z);
    acc[i * 8 + 6] += w * bflo(u.w); acc[i * 8 + 7] += w * bfhi(u.w);
  }
}
DI void gate_store(const bf16_t* __restrict__ gp, bf16_t* __restrict__ op, const float (&acc)[64], float scale) {
#pragma unroll
  for (int i = 0; i < 8; ++i) {
    uint4 u = *(const uint4*)(gp + i * 8);
    float g[8] = {bflo(u.x), bfhi(u.x), bflo(u.y), bfhi(u.y), bflo(u.z), bfhi(u.z), bflo(u.w), bfhi(u.w)};
    float o[8];
#pragma unroll
    for (int e = 0; e < 8; ++e) o[e] = acc[i * 8 + e] * scale * (g[e] / (1.f + __expf(-g[e])));
    uint4 w; w.x = pack2(o[0], o[1]); w.y = pack2(o[2], o[3]); w.z = pack2(o[4], o[5]); w.w = pack2(o[6], o[7]);
    *(uint4*)(op + i * 8) = w;
  }
}

DI void sb_naive_wave(const Params& p, int layer, int item, int lane) {
  const int qc = 31 - (item & 31), bh = item >> 5, h = bh % 6, b = bh / 6;
  const int t = qc * 64 + lane;
  const bf16_t* base = p.proj + (size_t)(b * T) * INC;
  float q[64], acc[64];
  load_row64(base + (size_t)t * INC + C_SBQ + h * 64, q, 0.125f);
#pragma unroll
  for (int d = 0; d < 64; ++d) acc[d] = 0.f;
  float carry = 0.f;
  for (int s = qc * 64 + 62; s >= 0; --s) {
    const bf16_t* kp = base + (size_t)s * INC + C_SBK + h * 64;
    float z = dot_row64(kp, q);
    bool act = s < t;
    float lb = fminf(z, 0.f) - log1pf(expf(-fabsf(z)));
    float w = act ? expf(lb + carry) : 0.f;
    carry += act ? (lb - z) : 0.f;
    axpy_row64(kp + (C_SBV - C_SBK), w, acc);
  }
  gate_store(base + (size_t)t * INC + C_SBG + h * 64, p.mixed + (size_t)(b * T + t) * 1024 + h * 64, acc, 1.f);
}

DI void os_step(const float (&q)[64], float& m, float& l, float (&acc)[64], const bf16_t* kp, const bf16_t* vp, bool valid) {
  float sc = dot_row64(kp, q);
  sc = valid ? sc : -1e30f;
  float mn = fmaxf(m, sc);
  float alpha = __expf(m - mn);
  float pw = valid ? __expf(sc - mn) : 0.f;
  l = l * alpha + pw;
  m = mn;
#pragma unroll
  for (int d = 0; d < 64; ++d) acc[d] *= alpha;
  axpy_row64(vp, pw, acc);
}

DI void moba_naive_wave(const Params& p, int layer, int item, int lane) {
  const int qc = 31 - (item & 31), bh = item >> 5, h = bh % 6, b = bh / 6;
  const int t = qc * 64 + lane, own = qc >> 2;
  const bf16_t* base = p.proj + (size_t)(b * T) * INC;
  float q[64], acc[64];
  load_row64(base + (size_t)t * INC + C_MBQ + h * 64, q, 1.f);
  unsigned sel = 0;
  if (own <= 3) sel = (1u << own) - 1u;
  else {
    float gate[8];
#pragma unroll
    for (int j = 0; j < 8; ++j) {
      float gsum = 0.f;
      if (j < own) {
        const float* km = p.kmean + ((layer * 8 + b) * 8 + j) * 384 + h * 64;
#pragma unroll
        for (int d = 0; d < 64; ++d) gsum += q[d] * km[d];
      }
      gate[j] = gsum;
    }
#pragma unroll
    for (int r = 0; r < 3; ++r) {
      float best = -3.0e38f; int bi = 0;
#pragma unroll
      for (int j = 0; j < 8; ++j) {
        bool ok = (j < own) && !((sel >> j) & 1u) && (gate[j] > best);
        best = ok ? gate[j] : best; bi = ok ? j : bi;
      }
      sel |= 1u << bi;
    }
  }
#pragma unroll
  for (int d = 0; d < 64; ++d) { acc[d] = 0.f; q[d] *= 0.125f; }
  float m = -1e30f, l = 0.f;
  for (int j = 0; j < own; ++j) {
    bool v = (sel >> j) & 1u;
    if (__ballot(v) == 0ull) continue;
    for (int s = j * 256; s < j * 256 + 256; ++s) {
      const bf16_t* kp = base + (size_t)s * INC + C_MBK + h * 64;
      os_step(q, m, l, acc, kp, kp + (C_MBV - C_MBK), v);
    }
  }
  for (int s = own * 256; s <= qc * 64 + 63; ++s) {
    const bf16_t* kp = base + (size_t)s * INC + C_MBK + h * 64;
    os_step(q, m, l, acc, kp, kp + (C_MBV - C_MBK), s <= t);
  }
  gate_store(base + (size_t)t * INC + C_MBG + h * 64, p.mixed + (size_t)(b * T + t) * 1024 + 384 + h * 64, acc, 1.f / l);
}

DI void mem_naive_wave(const Params& p, int layer, int item, int lane) {
  const int qc = item & 31, bh = item >> 5, h = bh & 3, b = bh >> 2;
  const int t = qc * 64 + lane;
  const bf16_t* base = p.proj + (size_t)(b * T) * INC;
  float q[64], acc[64];
  load_row64(base + (size_t)t * INC + C_MQ + h * 64, q, 0.125f);
#pragma unroll
  for (int d = 0; d < 64; ++d) acc[d] = 0.f;
  float m = -1e30f, l = 0.f;
  const bf16_t* kv = p.mkv + (size_t)layer * NMEM * 512 + (size_t)(b * MEML) * 512 + h * 64;
  for (int s = 0; s < MEML; ++s) os_step(q, m, l, acc, kv + (size_t)s * 512, kv + (size_t)s * 512 + 256, true);
  gate_store(base + (size_t)t * INC + C_MG + h * 64, p.mixed + (size_t)(b * T + t) * 1024 + 768 + h * 64, acc, 1.f / l);
}

__global__ void __launch_bounds__(256) attn_naive_sb(Params p, int layer) {
  sb_naive_wave(p, layer, blockIdx.x * 4 + (threadIdx.x >> 6), threadIdx.x & 63);
}
__global__ void __launch_bounds__(256) attn_naive_moba(Params p, int layer) {
  moba_naive_wave(p, layer, blockIdx.x * 4 + (threadIdx.x >> 6), threadIdx.x & 63);
}
__global__ void __launch_bounds__(256) attn_naive_mem(Params p, int layer) {
  mem_naive_wave(p, layer, blockIdx.x * 4 + (threadIdx.x >> 6), threadIdx.x & 63);
}

constexpr int AT_STR = 72;
constexpr float C2 = 0.125f * 1.4426950408889634f;

DI bf16x8 pack8(const f32x4& a, const f32x4& b) {
  u32x4 r;
  r[0] = pack2(a[0], a[1]); r[1] = pack2(a[2], a[3]); r[2] = pack2(b[0], b[1]); r[3] = pack2(b[2], b[3]);
  return __builtin_bit_cast(bf16x8, r);
}

struct TileSrc { const bf16_t* k; int kstride; const bf16_t* v; };

DI void tile_gload(const TileSrc& ts, int k0, int tid, u32x4 (&rk)[2], u32x4 (&rv)[2]) {
  const unsigned toff = (unsigned)((tid >> 3) * ts.kstride * 2 + (tid & 7) * 16);
#pragma unroll
  for (int i = 0; i < 2; ++i) {
    const char* kb = (const char*)ts.k + (size_t)(k0 + 32 * i) * ts.kstride * 2;
    const char* vb = (const char*)ts.v + (size_t)(k0 + 32 * i) * ts.kstride * 2;
    rk[i] = *(const u32x4*)(kb + toff);
    rv[i] = *(const u32x4*)(vb + toff);
  }
}
DI void tile_sstore(bf16_t* Ks, bf16_t* Vs, int tid, const u32x4 (&rk)[2], const u32x4 (&rv)[2]) {
#pragma unroll
  for (int i = 0; i < 2; ++i) {
    int c = tid + i * 256, row = c >> 3, ch = c & 7;
    int kk = row & 31;
    int rho = (row & 32) + ((kk >> 2) & 1) * 16 + (kk >> 3) * 4 + (kk & 3);
    *(u32x4*)(Ks + rho * AT_STR + ch * 8) = rk[i];
    *(u32x4*)(Vs + row * AT_STR + ch * 8) = rv[i];
  }
}

DI void st_mfma(const bf16_t* Ks, const bf16x8 (&qf)[2], f32x4 (&s)[4], int fr, int fq) {
#pragma unroll
  for (int i = 0; i < 4; ++i) {
    bf16x8 a0 = *(const bf16x8*)(Ks + (i * 16 + fr) * AT_STR + fq * 8);
    bf16x8 a1 = *(const bf16x8*)(Ks + (i * 16 + fr) * AT_STR + 32 + fq * 8);
    f32x4 z = {0.f, 0.f, 0.f, 0.f};
    z = __builtin_amdgcn_mfma_f32_16x16x32_bf16(a0, qf[0], z, 0, 0, 0);
    z = __builtin_amdgcn_mfma_f32_16x16x32_bf16(a1, qf[1], z, 0, 0, 0);
    s[i] = z;
  }
}
typedef short s16x4_t __attribute__((ext_vector_type(4)));
DI void pv_mfma(const bf16_t* Vs, const bf16x8 (&pw)[2][2], f32x4 (&o)[2][4], int fr, int fq) {
  const int q = fr >> 2, pp = fr & 3;
#pragma unroll
  for (int dt = 0; dt < 4; ++dt) {
#pragma unroll
    for (int st = 0; st < 2; ++st) {
      const bf16_t* a0p = Vs + (st * 32 + fq * 8 + q) * AT_STR + dt * 16 + 4 * pp;
      s16x4_t lo = __builtin_amdgcn_ds_read_tr16_b64_v4i16((__attribute__((address_space(3))) s16x4_t*)(a0p));
      s16x4_t hi = __builtin_amdgcn_ds_read_tr16_b64_v4i16((__attribute__((address_space(3))) s16x4_t*)(a0p + 4 * AT_STR));
      bf16x8 a = __builtin_shufflevector(lo, hi, 0, 1, 2, 3, 4, 5, 6, 7);
#pragma unroll
      for (int qg = 0; qg < 2; ++qg) o[qg][dt] = __builtin_amdgcn_mfma_f32_16x16x32_bf16(a, pw[qg][st], o[qg][dt], 0, 0, 0);
    }
  }
}

template <int KIND>
DI void attn_item(const Params& p, int layer, int item, char* smem, int g_tid) {
  const int tid = g_tid, lane = tid & 63, wid = tid >> 6, fr = lane & 15, fq = lane >> 4;
  bf16_t* Ksb[2]; bf16_t* Vsb[2];
  Ksb[0] = (bf16_t*)smem; Vsb[0] = Ksb[0] + 64 * AT_STR; Ksb[1] = Vsb[0] + 64 * AT_STR; Vsb[1] = Ksb[1] + 64 * AT_STR;
  unsigned* sU = (unsigned*)(smem + 4 * 64 * AT_STR * 2);
  int b, h, qt;
  const bf16_t *qbase, *gbase; bf16_t* obase; TileSrc ts;
  if (KIND == 0) {
    qt = 15 - (item & 15); int bh = item >> 4; h = bh % 6; b = bh / 6;
    const bf16_t* pb = p.proj + (size_t)(b * T) * INC;
    qbase = pb + C_SBQ + h * 64; gbase = pb + C_SBG + h * 64; ts.k = pb + C_SBK + h * 64; ts.kstride = INC;
    ts.v = pb + C_SBV + h * 64;
    obase = p.mixed + (size_t)(b * T) * 1024 + h * 64;
  } else if (KIND == 1) {
    qt = 15 - (item & 15); int bh = item >> 4; h = bh % 6; b = bh / 6;
    const bf16_t* pb = p.proj + (size_t)(b * T) * INC;
    qbase = pb + C_MBQ + h * 64; gbase = pb + C_MBG + h * 64; ts.k = pb + C_MBK + h * 64; ts.kstride = INC;
    ts.v = pb + C_MBV + h * 64;
    obase = p.mixed + (size_t)(b * T) * 1024 + 384 + h * 64;
  } else {
    qt = item & 15; int bh = item >> 4; h = bh & 3; b = bh >> 2;
    const bf16_t* pb = p.proj + (size_t)(b * T) * INC;
    qbase = pb + C_MQ + h * 64; gbase = pb + C_MG + h * 64;
    ts.k = p.mkv + (size_t)layer * NMEM * 512 + (size_t)(b * MEML) * 512 + h * 64; ts.kstride = 512;
    ts.v = ts.k + 256;
    obase = p.mixed + (size_t)(b * T) * 1024 + 768 + h * 64;
  }
  const int q0 = qt * 128;
  const int tmin = q0 + wid * 32, tmax = tmin + 31;
  bf16x8 qf[2][2];
#pragma unroll
  for (int qg = 0; qg < 2; ++qg)
#pragma unroll
    for (int ks = 0; ks < 2; ++ks)
      qf[qg][ks] = *(const bf16x8*)(qbase + (size_t)(tmin + qg * 16 + fr) * INC + ks * 32 + fq * 8);

  const int own = q0 >> 8, own_start = own << 8;
  u32x4 rk[2], rv[2], rk2[2], rv2[2];
  tile_gload(ts, KIND == 0 ? ((q0 >> 6) + 1) * 64 : (KIND == 1 ? own_start : 0), tid, rk, rv);
  int ntile; unsigned U = 0; int n_own = 0;
  unsigned sel[2] = {0u, 0u};
  if (KIND == 0) ntile = (q0 >> 6) + 2;
  else if (KIND == 2) ntile = 4;
  else {
    n_own = ((q0 - own_start) >> 6) + 2;
    if (own <= 3) { U = (1u << own) - 1u; sel[0] = sel[1] = U; }
    else {
      f32x4 ga[2];
      ga[0] = f32x4{0.f, 0.f, 0.f, 0.f}; ga[1] = ga[0];
#pragma unroll
      for (int ks = 0; ks < 2; ++ks) {
        float kmv[8];
        const float* kmp = p.kmean + (size_t)((layer * 8 + b) * 8 + (fr & 7)) * 384 + h * 64 + ks * 32 + fq * 8;
        float4 k0v = *(const float4*)kmp, k1v = *(const float4*)(kmp + 4);
        kmv[0] = k0v.x; kmv[1] = k0v.y; kmv[2] = k0v.z; kmv[3] = k0v.w; kmv[4] = k1v.x; kmv[5] = k1v.y; kmv[6] = k1v.z; kmv[7] = k1v.w;
        u32x4 hi, lo;
#pragma unroll
        for (int e = 0; e < 4; ++e) {
          float x0 = (fr < 8) ? kmv[2 * e] : 0.f, x1 = (fr < 8) ? kmv[2 * e + 1] : 0.f;
          bf16_t h0 = f2bf(x0), h1 = f2bf(x1);
          hi[e] = (unsigned)h0 | ((unsigned)h1 << 16);
          lo[e] = pack2(x0 - bf2f(h0), x1 - bf2f(h1));
        }
        bf16x8 ah = __builtin_bit_cast(bf16x8, hi), al = __builtin_bit_cast(bf16x8, lo);
#pragma unroll
        for (int qg = 0; qg < 2; ++qg) {
          ga[qg] = __builtin_amdgcn_mfma_f32_16x16x32_bf16(ah, qf[qg][ks], ga[qg], 0, 0, 0);
          ga[qg] = __builtin_amdgcn_mfma_f32_16x16x32_bf16(al, qf[qg][ks], ga[qg], 0, 0, 0);
        }
      }
#pragma unroll
      for (int qg = 0; qg < 2; ++qg) {
        float gate[8];
#pragma unroll
        for (int j = 0; j < 4; ++j) {
          float mine = ga[qg][j], oth = shfl16(mine);
          gate[j] = (fq & 1) ? oth : mine;
          gate[4 + j] = (fq & 1) ? mine : oth;
        }
        unsigned sl = 0;
#pragma unroll
        for (int r = 0; r < 3; ++r) {
          float best = -3.0e38f; int bi = 0;
#pragma unroll
          for (int j = 0; j < 8; ++j) {
            bool ok = (j < own) && !((sl >> j) & 1u) && (gate[j] > best);
            best = ok ? gate[j] : best; bi = ok ? j : bi;
          }
          sl |= 1u << bi;
        }
        sl = __shfl(sl, lane & 31);
        sel[qg] = sl;
      }
      unsigned u = sel[0] | sel[1];
#pragma unroll
      for (int o = 32; o >= 1; o >>= 1) u |= __shfl_xor(u, o);
      __syncthreads();
      if (tid == 0) *sU = 0u;
      __syncthreads();
      if (lane == 0) atomicOr(sU, u);
      __syncthreads();
      U = *sU;
    }
    ntile = n_own + 4 * __popc(U);
  }
  auto tile_k0 = [&](int i) -> int {
    if (KIND == 0) return (ntile - 1 - i) * 64;
    if (KIND == 2) return i * 64;
    if (i < n_own) return own_start + i * 64;
    int ii = i - n_own, nb = ii >> 2, blk = 0; unsigned u = U;
    for (int c = 0; c < nb; ++c) u &= u - 1;
    blk = __ffs(u) - 1;
    return blk * 256 + (ii & 3) * 64;
  };

  f32x4 o[2][4];
#pragma unroll
  for (int qg = 0; qg < 2; ++qg)
#pragma unroll
    for (int dt = 0; dt < 4; ++dt) o[qg][dt] = f32x4{0.f, 0.f, 0.f, 0.f};
  float carry[2] = {1.f, 1.f};
  float mrun[2] = {-1e30f, -1e30f}, lrun[2] = {0.f, 0.f};

  __syncthreads();
  tile_sstore(Ksb[0], Vsb[0], tid, rk, rv);
  if (ntile > 1) tile_gload(ts, tile_k0(1), tid, rk, rv);
  __syncthreads();
  auto step = [&](const int i, u32x4 (&lk)[2], u32x4 (&lv)[2], const u32x4 (&sk)[2], const u32x4 (&sv2)[2]) -> bool {
    const int k0 = tile_k0(i);
    const bf16_t* Ks = Ksb[i & 1]; const bf16_t* Vs = Vsb[i & 1];
    if (i + 2 < ntile) tile_gload(ts, tile_k0(i + 2), tid, lk, lv);
    bool skip = false, diag = false;
    if (KIND == 0) { skip = (k0 >= tmax); diag = (k0 + 63 >= tmin); }
    if (KIND == 1 && i < n_own) { skip = (k0 > tmax); diag = (k0 + 63 > tmin); }
    if (!skip) {
      bf16x8 pw[2][2];
      if (KIND == 0) {
#pragma unroll
        for (int qg = 0; qg < 2; ++qg) {
          const int t = tmin + qg * 16 + fr;
          f32x4 s[4];
          st_mfma(Ks, qf[qg], s, fr, fq);
          float om[16], be[16];
#pragma unroll
          for (int ii = 0; ii < 4; ++ii)
#pragma unroll
            for (int j = 0; j < 4; ++j) {
              const int e = ii * 4 + j;
              float z2 = fmaxf(s[ii][j] * C2, -100.f);
              float ex = __builtin_amdgcn_exp2f(-z2);
              float r = __builtin_amdgcn_rcpf(1.f + ex);
              be[e] = r; om[e] = ex * r;
            }
          if (diag) {
            asm volatile("" ::: "memory");
#pragma unroll
            for (int ii = 0; ii < 4; ++ii)
#pragma unroll
              for (int j = 0; j < 4; ++j) {
                const int e = ii * 4 + j;
                const int key = k0 + (ii >> 1) * 32 + 8 * fq + (ii & 1) * 4 + j;
                const bool act = key < t;
                be[e] = act ? be[e] : 0.f; om[e] = act ? om[e] : 1.f;
              }
          }
          float cp0 = om[0], cp1 = om[8];
#pragma unroll
          for (int e = 1; e < 8; ++e) { cp0 *= om[e]; cp1 *= om[8 + e]; }
          float a0 = shfl16(cp0), a1 = shfl16(cp1);
          float pr0 = cp0 * a0, pr1 = cp1 * a1;
          float b0 = shfl32(pr0), b1 = shfl32(pr1);
          float tot0 = pr0 * b0, tot1 = pr1 * b1;
          float sfx0 = (fq == 0) ? a0 * b0 : (fq == 1) ? b0 : (fq == 2) ? a0 : 1.f;
          float sfx1 = (fq == 0) ? a1 * b1 : (fq == 1) ? b1 : (fq == 2) ? a1 : 1.f;
          float w[16];
          float P = carry[qg] * sfx1;
#pragma unroll
          for (int e = 15; e >= 8; --e) { w[e] = be[e] * P; P *= om[e]; }
          P = carry[qg] * tot1 * sfx0;
#pragma unroll
          for (int e = 7; e >= 0; --e) { w[e] = be[e] * P; P *= om[e]; }
          carry[qg] *= tot1 * tot0;
          f32x4 w0 = {w[0], w[1], w[2], w[3]}, w1 = {w[4], w[5], w[6], w[7]};
          f32x4 w2 = {w[8], w[9], w[10], w[11]}, w3 = {w[12], w[13], w[14], w[15]};
          pw[qg][0] = pack8(w0, w1); pw[qg][1] = pack8(w2, w3);
        }
      } else {
#pragma unroll
        for (int qg = 0; qg < 2; ++qg) {
          const int t = tmin + qg * 16 + fr;
          f32x4 s[4];
          st_mfma(Ks, qf[qg], s, fr, fq);
          float sv[16];
          bool lanevalid = true;
          if (KIND == 1 && i >= n_own) lanevalid = (sel[qg] >> (k0 >> 8)) & 1u;
          float mx = -3.0e38f;
#pragma unroll
          for (int ii = 0; ii < 4; ++ii)
#pragma unroll
            for (int j = 0; j < 4; ++j) {
              const int e = ii * 4 + j;
              sv[e] = s[ii][j];
            }
          if (KIND == 1 && diag) {
            asm volatile("" ::: "memory");
#pragma unroll
            for (int ii = 0; ii < 4; ++ii)
#pragma unroll
              for (int j = 0; j < 4; ++j) {
                const int key = k0 + (ii >> 1) * 32 + 8 * fq + (ii & 1) * 4 + j;
                sv[ii * 4 + j] = (key <= t) ? sv[ii * 4 + j] : -3.0e38f;
              }
          }
#pragma unroll
          for (int e = 0; e < 16; ++e) mx = fmaxf(mx, sv[e]);
          mx = lanevalid ? mx : -3.0e38f;
          mx = fmaxf(mx, shfl16(mx));
          mx = fmaxf(mx, shfl32(mx));
          const float mnew = fmaxf(mrun[qg], mx * C2);
          const float alpha = __builtin_amdgcn_exp2f(mrun[qg] - mnew);
          mrun[qg] = mnew;
          const float c2e = lanevalid ? C2 : 0.f, nb = lanevalid ? -mnew : -1e30f;
          float ps = 0.f;
#pragma unroll
          for (int e = 0; e < 16; ++e) { sv[e] = __builtin_amdgcn_exp2f(__builtin_fmaf(sv[e], c2e, nb)); ps += sv[e]; }
          lrun[qg] = lrun[qg] * alpha + ps;
          if (__any(alpha != 1.f)) {
#pragma unroll
            for (int dt = 0; dt < 4; ++dt) o[qg][dt] *= alpha;
          }
          f32x4 w0 = {sv[0], sv[1], sv[2], sv[3]}, w1 = {sv[4], sv[5], sv[6], sv[7]};
          f32x4 w2 = {sv[8], sv[9], sv[10], sv[11]}, w3 = {sv[12], sv[13], sv[14], sv[15]};
          pw[qg][0] = pack8(w0, w1); pw[qg][1] = pack8(w2, w3);
        }
      }
      pv_mfma(Vs, pw, o, fr, fq);
    }
    if (i + 1 < ntile) tile_sstore(Ksb[(i + 1) & 1], Vsb[(i + 1) & 1], tid, sk, sv2);
    if (KIND == 0) {
      const int live = (carry[0] >= 1.17549435e-38f) || (carry[1] >= 1.17549435e-38f);
      if (!__syncthreads_or(live)) return true;
    } else {
      __syncthreads();
    }
    return false;
  };
#pragma unroll 1
  for (int i = 0; i < ntile; i += 2) {
    if (step(i, rk2, rv2, rk, rv)) break;
    if (i + 1 < ntile) { if (step(i + 1, rk, rv, rk2, rv2)) break; }
  }
#pragma unroll
  for (int qg = 0; qg < 2; ++qg) {
    const int t = tmin + qg * 16 + fr;
    float scale = 1.f;
    if (KIND != 0) {
      float l = lrun[qg];
      l += shfl16(l); l += shfl32(l);
      scale = 1.f / l;
    }
#pragma unroll
    for (int dt = 0; dt < 4; ++dt) {
      uint2 gu = *(const uint2*)(gbase + (size_t)t * INC + dt * 16 + fq * 4);
      float g0 = bflo(gu.x), g1 = bfhi(gu.x), g2 = bflo(gu.y), g3 = bfhi(gu.y);
      float r0 = o[qg][dt][0] * scale * g0 * __builtin_amdgcn_rcpf(1.f + __builtin_amdgcn_exp2f(-1.4426950408889634f * g0));
      float r1 = o[qg][dt][1] * scale * g1 * __builtin_amdgcn_rcpf(1.f + __builtin_amdgcn_exp2f(-1.4426950408889634f * g1));
      float r2 = o[qg][dt][2] * scale * g2 * __builtin_amdgcn_rcpf(1.f + __builtin_amdgcn_exp2f(-1.4426950408889634f * g2));
      float r3 = o[qg][dt][3] * scale * g3 * __builtin_amdgcn_rcpf(1.f + __builtin_amdgcn_exp2f(-1.4426950408889634f * g3));
      uint2 ou; ou.x = pack2(r0, r1); ou.y = pack2(r2, r3);
      *(uint2*)(obase + (size_t)t * 1024 + dt * 16 + fq * 4) = ou;
    }
  }
}

using f32x16 = __attribute__((ext_vector_type(16))) float;
template <int KIND>
DI void attn_item32(const Params& p, int layer, int item, char* smem, int g_tid) {
  const int tid = g_tid, lane = tid & 63, wid = tid >> 6, q = lane & 31, hh = lane >> 5;
  bf16_t* Ksb[2]; bf16_t* Vsb[2];
  Ksb[0] = (bf16_t*)smem; Vsb[0] = Ksb[0] + 64 * AT_STR; Ksb[1] = Vsb[0] + 64 * AT_STR; Vsb[1] = Ksb[1] + 64 * AT_STR;
  unsigned* sU = (unsigned*)(smem + 4 * 64 * AT_STR * 2);
  int b, h, qt;
  const bf16_t *qbase, *gbase; bf16_t* obase; TileSrc ts;
  if (KIND == 0) {
    qt = 15 - (item & 15); int bh = item >> 4; h = bh % 6; b = bh / 6;
    const bf16_t* pb = p.proj + (size_t)(b * T) * INC;
    qbase = pb + C_SBQ + h * 64; gbase = pb + C_SBG + h * 64; ts.k = pb + C_SBK + h * 64; ts.kstride = INC;
    ts.v = pb + C_SBV + h * 64;
    obase = p.mixed + (size_t)(b * T) * 1024 + h * 64;
  } else if (KIND == 1) {
    qt = 15 - (item & 15); int bh = item >> 4; h = bh % 6; b = bh / 6;
    const bf16_t* pb = p.proj + (size_t)(b * T) * INC;
    qbase = pb + C_MBQ + h * 64; gbase = pb + C_MBG + h * 64; ts.k = pb + C_MBK + h * 64; ts.kstride = INC;
    ts.v = pb + C_MBV + h * 64;
    obase = p.mixed + (size_t)(b * T) * 1024 + 384 + h * 64;
  } else {
    qt = item & 15; int bh = item >> 4; h = bh & 3; b = bh >> 2;
    const bf16_t* pb = p.proj + (size_t)(b * T) * INC;
    qbase = pb + C_MQ + h * 64; gbase = pb + C_MG + h * 64;
    ts.k = p.mkv + (size_t)layer * NMEM * 512 + (size_t)(b * MEML) * 512 + h * 64; ts.kstride = 512;
    ts.v = ts.k + 256;
    obase = p.mixed + (size_t)(b * T) * 1024 + 768 + h * 64;
  }
  const int q0 = qt * 128;
  const int tmin = q0 + wid * 32, tmax = tmin + 31;
  const int t = tmin + q;
  bf16x8 qf[4];
#pragma unroll
  for (int ks = 0; ks < 4; ++ks) qf[ks] = *(const bf16x8*)(qbase + (size_t)t * INC + ks * 16 + hh * 8);
  uint2 gpre[2][4];
#pragma unroll
  for (int dt2 = 0; dt2 < 2; ++dt2)
#pragma unroll
    for (int g4 = 0; g4 < 4; ++g4) gpre[dt2][g4] = *(const uint2*)(gbase + (size_t)t * INC + dt2 * 32 + 8 * g4 + 4 * hh);
  const int own = q0 >> 8, own_start = own << 8;
  u32x4 rk[2], rv[2], rk2[2], rv2[2];
  tile_gload(ts, KIND == 0 ? ((q0 >> 6) + 1) * 64 : (KIND == 1 ? own_start : 0), tid, rk, rv);
  int ntile; unsigned U = 0; int n_own = 0; unsigned sel = 0u;
  if (KIND == 0) ntile = (q0 >> 6) + 2;
  else if (KIND == 2) ntile = 4;
  else {
    n_own = ((q0 - own_start) >> 6) + 2;
    if (own <= 3) { U = (1u << own) - 1u; sel = U; }
    else {
      f32x16 ga;
#pragma unroll
      for (int i = 0; i < 16; ++i) ga[i] = 0.f;
#pragma unroll
      for (int ks = 0; ks < 4; ++ks) {
        const float* kmp = p.kmean + (size_t)((layer * 8 + b) * 8 + (q & 7)) * 384 + h * 64 + ks * 16 + hh * 8;
        float4 k0v = *(const float4*)kmp, k1v = *(const float4*)(kmp + 4);
        float kmv[8] = {k0v.x, k0v.y, k0v.z, k0v.w, k1v.x, k1v.y, k1v.z, k1v.w};
        u32x4 hi, lo;
#pragma unroll
        for (int e = 0; e < 4; ++e) {
          float x0 = (q < 8) ? kmv[2 * e] : 0.f, x1 = (q < 8) ? kmv[2 * e + 1] : 0.f;
          bf16_t h0 = f2bf(x0), h1 = f2bf(x1);
          hi[e] = (unsigned)h0 | ((unsigned)h1 << 16);
          lo[e] = pack2(x0 - bf2f(h0), x1 - bf2f(h1));
        }
        ga = __builtin_amdgcn_mfma_f32_32x32x16_bf16(__builtin_bit_cast(bf16x8, hi), qf[ks], ga, 0, 0, 0);
        ga = __builtin_amdgcn_mfma_f32_32x32x16_bf16(__builtin_bit_cast(bf16x8, lo), qf[ks], ga, 0, 0, 0);
      }
      float gate[8];
#pragma unroll
      for (int j = 0; j < 4; ++j) {
        const float mine = ga[j], oth = shfl32(mine);
        gate[j] = hh ? oth : mine;
        gate[4 + j] = hh ? mine : oth;
      }
      unsigned sl = 0;
#pragma unroll
      for (int r = 0; r < 3; ++r) {
        float best = -3.0e38f; int bi = 0;
#pragma unroll
        for (int j = 0; j < 8; ++j) {
          bool ok = (j < own) && !((sl >> j) & 1u) && (gate[j] > best);
          best = ok ? gate[j] : best; bi = ok ? j : bi;
        }
        sl |= 1u << bi;
      }
      sel = sl;
      unsigned u = sel;
#pragma unroll
      for (int o = 32; o >= 1; o >>= 1) u |= __shfl_xor(u, o);
      __syncthreads();
      if (tid == 0) *sU = 0u;
      __syncthreads();
      if (lane == 0) atomicOr(sU, u);
      __syncthreads();
      U = *sU;
    }
    ntile = n_own + 4 * __popc(U);
  }
  auto tile_k0 = [&](int i) -> int {
    if (KIND == 0) return (ntile - 1 - i) * 64;
    if (KIND == 2) return i * 64;
    if (i < n_own) return own_start + i * 64;
    int ii = i - n_own, nb = ii >> 2, blk = 0; unsigned u = U;
    for (int c = 0; c < nb; ++c) u &= u - 1;
    blk = __ffs(u) - 1;
    return blk * 256 + (ii & 3) * 64;
  };
  f32x16 o[2];
#pragma unroll
  for (int dt2 = 0; dt2 < 2; ++dt2)
#pragma unroll
    for (int i = 0; i < 16; ++i) o[dt2][i] = 0.f;
  float mrun = -1e30f, lrun = 0.f;
  float carry = 1.f;
  const int qa = (q >> 2) & 1, qb = q >> 3, qc = q & 3;
  const int krow0 = (qb & 1) * 16 + (2 * qa + (qb >> 1)) * 4 + qc;
  const int vq4 = (lane & 15) >> 2, vp4 = lane & 3, vblk = (lane >> 4) & 1;

  __syncthreads();
  tile_sstore(Ksb[0], Vsb[0], tid, rk, rv);
  if (ntile > 1) tile_gload(ts, tile_k0(1), tid, rk, rv);
  __syncthreads();
  auto step = [&](const int i, u32x4 (&lk)[2], u32x4 (&lv)[2], const u32x4 (&sk)[2], const u32x4 (&sv2)[2]) -> bool {
    const int k0 = tile_k0(i);
    const bf16_t* Ks = Ksb[i & 1]; const bf16_t* Vs = Vsb[i & 1];
    if (i + 2 < ntile) tile_gload(ts, tile_k0(i + 2), tid, lk, lv);
    bool skip = false, diag = false;
    if (KIND == 0) { skip = (k0 >= tmax); diag = (k0 + 63 >= tmin); }
    if (KIND == 1 && i < n_own) { skip = (k0 > tmax); diag = (k0 + 63 > tmin); }
    if (!skip) {
      f32x16 s[2];
      float om[2][16];
#pragma unroll
      for (int kt2 = 0; kt2 < 2; ++kt2) {
        f32x16 z;
#pragma unroll
        for (int e = 0; e < 16; ++e) z[e] = 0.f;
#pragma unroll
        for (int ks = 0; ks < 4; ++ks) {
          const bf16x8 a = *(const bf16x8*)(Ks + (kt2 * 32 + krow0) * AT_STR + ks * 16 + hh * 8);
          z = __builtin_amdgcn_mfma_f32_32x32x16_bf16(a, qf[ks], z, 0, 0, 0);
        }
        s[kt2] = z;
      }
      if (KIND == 0) {
#pragma unroll
        for (int kt2 = 0; kt2 < 2; ++kt2)
#pragma unroll
          for (int e = 0; e < 16; ++e) {
            const float z2 = fmaxf(s[kt2][e] * C2, -100.f);
            const float ex = __builtin_amdgcn_exp2f(-z2);
            const float r = __builtin_amdgcn_rcpf(1.f + ex);
            s[kt2][e] = r; om[kt2][e] = ex * r;
          }
        if (diag) {
          asm volatile("" ::: "memory");
#pragma unroll
          for (int kt2 = 0; kt2 < 2; ++kt2)
#pragma unroll
            for (int e = 0; e < 16; ++e) {
              const bool act = (k0 + kt2 * 32 + 16 * hh + e) < t;
              s[kt2][e] = act ? s[kt2][e] : 0.f; om[kt2][e] = act ? om[kt2][e] : 1.f;
            }
        }
        float cp0 = om[0][0], cp1 = om[1][0];
#pragma unroll
        for (int e = 1; e < 16; ++e) { cp0 *= om[0][e]; cp1 *= om[1][e]; }
        const float oc0 = shfl32(cp0), oc1 = shfl32(cp1);
        const float tot0 = cp0 * oc0, tot1 = cp1 * oc1;
        float P = carry * (hh ? 1.f : oc1);
#pragma unroll
        for (int e = 15; e >= 0; --e) { const float w = s[1][e] * P; P *= om[1][e]; s[1][e] = w; }
        P = carry * tot1 * (hh ? 1.f : oc0);
#pragma unroll
        for (int e = 15; e >= 0; --e) { const float w = s[0][e] * P; P *= om[0][e]; s[0][e] = w; }
        carry *= tot0 * tot1;
      } else {
      bool lanevalid = true;
      if (KIND == 1 && i >= n_own) lanevalid = (sel >> (k0 >> 8)) & 1u;
      if (KIND == 1 && diag) {
        asm volatile("" ::: "memory");
#pragma unroll
        for (int kt2 = 0; kt2 < 2; ++kt2)
#pragma unroll
          for (int e = 0; e < 16; ++e) {
            const int key = k0 + kt2 * 32 + 16 * hh + e;
            s[kt2][e] = (key <= t) ? s[kt2][e] : -3.0e38f;
          }
      }
      float mx = -3.0e38f;
#pragma unroll
      for (int kt2 = 0; kt2 < 2; ++kt2)
#pragma unroll
        for (int e = 0; e < 16; ++e) mx = fmaxf(mx, s[kt2][e]);
      mx = lanevalid ? mx : -3.0e38f;
      mx = fmaxf(mx, shfl32(mx));
      const float mnew = fmaxf(mrun, mx * C2);
      const float alpha = __builtin_amdgcn_exp2f(mrun - mnew);
      mrun = mnew;
      const float c2e = lanevalid ? C2 : 0.f, nb = lanevalid ? -mnew : -1e30f;
      float ps = 0.f;
#pragma unroll
      for (int kt2 = 0; kt2 < 2; ++kt2)
#pragma unroll
        for (int e = 0; e < 16; ++e) { s[kt2][e] = __builtin_amdgcn_exp2f(__builtin_fmaf(s[kt2][e], c2e, nb)); ps += s[kt2][e]; }
      lrun = lrun * alpha + ps;
      if (__any(alpha != 1.f)) {
#pragma unroll
        for (int dt2 = 0; dt2 < 2; ++dt2) o[dt2] *= alpha;
      }
      }
      bf16x8 pw[2][2];
#pragma unroll
      for (int kt2 = 0; kt2 < 2; ++kt2)
#pragma unroll
        for (int s2 = 0; s2 < 2; ++s2) {
          f32x4 w0 = {s[kt2][8 * s2 + 0], s[kt2][8 * s2 + 1], s[kt2][8 * s2 + 2], s[kt2][8 * s2 + 3]};
          f32x4 w1 = {s[kt2][8 * s2 + 4], s[kt2][8 * s2 + 5], s[kt2][8 * s2 + 6], s[kt2][8 * s2 + 7]};
          pw[kt2][s2] = pack8(w0, w1);
        }
#pragma unroll
      for (int dt2 = 0; dt2 < 2; ++dt2)
#pragma unroll
        for (int kt2 = 0; kt2 < 2; ++kt2)
#pragma unroll
          for (int s2 = 0; s2 < 2; ++s2) {
            const bf16_t* vp = Vs + (kt2 * 32 + 16 * hh + 8 * s2 + vq4) * AT_STR + dt2 * 32 + vblk * 16 + 4 * vp4;
            s16x4_t lo = __builtin_amdgcn_ds_read_tr16_b64_v4i16((__attribute__((address_space(3))) s16x4_t*)(vp));
            s16x4_t hi = __builtin_amdgcn_ds_read_tr16_b64_v4i16((__attribute__((address_space(3))) s16x4_t*)(vp + 4 * AT_STR));
            bf16x8 a = __builtin_shufflevector(lo, hi, 0, 1, 2, 3, 4, 5, 6, 7);
            o[dt2] = __builtin_amdgcn_mfma_f32_32x32x16_bf16(a, pw[kt2][s2], o[dt2], 0, 0, 0);
          }
    }
    if (i + 1 < ntile) tile_sstore(Ksb[(i + 1) & 1], Vsb[(i + 1) & 1], tid, sk, sv2);
    if (KIND == 0) {
      if (!__syncthreads_or(carry >= 1.17549435e-38f)) return true;
    } else {
      __syncthreads();
    }
    return false;
  };
#pragma unroll 1
  for (int i = 0; i < ntile; i += 2) {
    if (step(i, rk2, rv2, rk, rv)) break;
    if (i + 1 < ntile) { if (step(i + 1, rk, rv, rk2, rv2)) break; }
  }
  {
    float l = lrun;
    l += shfl32(l);
    const float scale = (KIND == 0) ? 1.f : __builtin_amdgcn_rcpf(l);
#pragma unroll
    for (int dt2 = 0; dt2 < 2; ++dt2)
#pragma unroll
      for (int g4 = 0; g4 < 4; ++g4) {
        const int d0 = dt2 * 32 + 8 * g4 + 4 * hh;
        const uint2 gu = gpre[dt2][g4];
        const float gg[4] = {bflo(gu.x), bfhi(gu.x), bflo(gu.y), bfhi(gu.y)};
        float r[4];
#pragma unroll
        for (int j = 0; j < 4; ++j)
          r[j] = o[dt2][g4 * 4 + j] * scale * gg[j] * __builtin_amdgcn_rcpf(1.f + __builtin_amdgcn_exp2f(-1.4426950408889634f * gg[j]));
        uint2 ou; ou.x = pack2(r[0], r[1]); ou.y = pack2(r[2], r[3]);
        *(uint2*)(obase + (size_t)t * 1024 + d0) = ou;
      }
  }
}

DI void phase_attn(const Params& p, int layer, char* smem, int g_tid, int g_bid) {
  int* s_item = (int*)(smem + 4 * 64 * AT_STR * 2 + 16);
  unsigned* qctr = p.bar + 3456 + layer * 16;
  for (;;) {
    __syncthreads();
    if (g_tid == 0) *s_item = (int)atomicAdd(qctr, 1u);
    __syncthreads();
    const int it = *s_item;
    if (it >= 2048) break;
    if (it < 768) { int qrank = it / 48, bh = it % 48; attn_item32<1>(p, layer, bh * 16 + qrank, smem, g_tid); }
    else if (it < 1536) { int u = it - 768; int qrank = u / 48, bh = u % 48; attn_item32<0>(p, layer, bh * 16 + qrank, smem, g_tid); }
    else attn_item32<2>(p, layer, it - 1536, smem, g_tid);
  }
}

DI void phase_final(const Params& p, int g_tid, int g_bid) {
  const int lane = g_tid & 63, wid = g_tid >> 6;
  const int stride = gridDim.x * 4;
  float4 g[2][2];
#pragma unroll
  for (int i = 0; i < 2; ++i) { g[i][0] = *(const float4*)(p.final_g + i * 512 + lane * 8); g[i][1] = *(const float4*)(p.final_g + i * 512 + lane * 8 + 4); }
  for (int r0 = g_bid * 4 + wid; r0 < NTOK; r0 += 4 * stride) {
    uint4 v[4][2]; float ssv[4];
#pragma unroll
    for (int u = 0; u < 4; ++u) {
      const int r = r0 + u * stride;
      if (r < NTOK) {
        ssv[u] = p.ss[2 * NTOK + r];
#pragma unroll
        for (int i = 0; i < 2; ++i) v[u][i] = *(const uint4*)(p.xb + (size_t)r * 1024 + i * 512 + lane * 8);
      }
    }
#pragma unroll
    for (int u = 0; u < 4; ++u) {
      const int r = r0 + u * stride;
      if (r < NTOK) {
        const float rs = rsqrtf(ssv[u] * (1.f / 1024.f) + 1e-6f);
#pragma unroll
        for (int i = 0; i < 2; ++i) {
          const uint4 w = v[u][i];
          float4 o0, o1;
          o0.x = bflo(w.x) * rs * g[i][0].x; o0.y = bfhi(w.x) * rs * g[i][0].y; o0.z = bflo(w.y) * rs * g[i][0].z; o0.w = bfhi(w.y) * rs * g[i][0].w;
          o1.x = bflo(w.z) * rs * g[i][1].x; o1.y = bfhi(w.z) * rs * g[i][1].y; o1.z = bflo(w.w) * rs * g[i][1].z; o1.w = bfhi(w.w) * rs * g[i][1].w;
          *(float4*)(p.out + (size_t)r * 1024 + i * 512 + lane * 8) = o0;
          *(float4*)(p.out + (size_t)r * 1024 + i * 512 + lane * 8 + 4) = o1;
        }
      }
    }
  }
}

#define XB_TMO      128
#define XB_XCNT(j)  (256  + 64 * (j))
#define XB_XSUB(j)  (1280 + 64 * (j))
#define XB_XGEN(j)  (2304 + 64 * (j))
#define XB_TOP      3328
#define XB_TOPGEN   3392
#define XCD_BAR_WORDS 3456
#define XB_SPIN_CAP (1u << 18)
#define LAS __attribute__((address_space(3)))
DI unsigned xb_ld(unsigned* p) { return __hip_atomic_load(p, __ATOMIC_RELAXED, __HIP_MEMORY_SCOPE_AGENT); }
DI unsigned xb_add(unsigned* p, unsigned v) { return __hip_atomic_fetch_add(p, v, __ATOMIC_RELAXED, __HIP_MEMORY_SCOPE_AGENT); }
DI unsigned xb_xcc_id() { return (unsigned)__builtin_amdgcn_s_getreg((3 << 11) | 20) & 0xFu; }
#define XB_SPIN(cond, bar) do { unsigned _sp = 0; while (cond) { __builtin_amdgcn_s_sleep(1); \
    if ((++_sp & 255u) == 0u) { if (xb_ld(&(bar)[XB_TMO])) break; if (_sp > XB_SPIN_CAP) { atomicAdd(&(bar)[XB_TMO], 1u); break; } } } } while (0)
struct XcdBarrier { unsigned* bar; unsigned x; volatile LAS unsigned* st; };
DI XcdBarrier xcd_barrier_post(unsigned* bar, volatile LAS unsigned* st) {
  XcdBarrier b; b.bar = bar; b.x = xb_xcc_id(); b.st = st;
  if (threadIdx.x == 0) (void)xb_add(&bar[XB_XCNT(b.x)], 1u);
  return b;
}
DI void xcd_barrier_complete(unsigned* bar, unsigned x, unsigned& nloc, unsigned& nx) {
  const unsigned G = gridDim.x * gridDim.y * gridDim.z;
  unsigned sum, cnt, mine, sp = 0u;
  for (;;) {
    sum = 0u; cnt = 0u; mine = 0u;
#pragma unroll
    for (unsigned j = 0; j < 16; ++j) { const unsigned c = xb_ld(&bar[XB_XCNT(j)]); sum += c; cnt += (c > 0u) ? 1u : 0u; mine = (j == x) ? c : mine; }
    if (sum == G) break;
    __builtin_amdgcn_s_sleep(1);
    if ((++sp & 255u) == 0u) { if (xb_ld(&bar[XB_TMO])) break; if (sp > XB_SPIN_CAP) { atomicAdd(&bar[XB_TMO], 1u); break; } }
  }
  nloc = mine > 0u ? mine : 1u; nx = cnt > 0u ? cnt : 1u;
}
DI void xcd_barrier(const XcdBarrier& b) {
  asm volatile("s_waitcnt vmcnt(0)" ::: "memory");
  __syncthreads();
  if (threadIdx.x == 0) {
    unsigned* bar = b.bar;
    __builtin_amdgcn_s_waitcnt(0);
    unsigned nloc = b.st[0], nx = b.st[1];
    if (nloc == 0u) { xcd_barrier_complete(bar, b.x, nloc, nx); b.st[0] = nloc; b.st[1] = nx; }
    const unsigned old = xb_add(&bar[XB_XSUB(b.x)], 1u);
    const unsigned gen = old / nloc;
    if (old + 1u == (gen + 1u) * nloc) {
      __builtin_amdgcn_fence(__ATOMIC_RELEASE, "agent");
      asm volatile("s_waitcnt vmcnt(0)" ::: "memory");
      const unsigned og = xb_add(&bar[XB_TOP], 1u);
      const unsigned tg = og / nx;
      if (og + 1u == (tg + 1u) * nx) xb_add(&bar[XB_TOPGEN], 1u);
      else XB_SPIN(xb_ld(&bar[XB_TOPGEN]) == tg, bar);
      __builtin_amdgcn_fence(__ATOMIC_ACQUIRE, "agent");
      xb_add(&bar[XB_XGEN(b.x)], 1u);
      asm volatile("s_waitcnt vmcnt(0)" ::: "memory");
    } else {
      XB_SPIN(xb_ld(&bar[XB_XGEN(b.x)]) == gen, bar);
      __builtin_amdgcn_fence(__ATOMIC_ACQUIRE, "agent");
      asm volatile("s_waitcnt vmcnt(0)" ::: "memory");
    }
  }
  __syncthreads();
}

constexpr int NPHASE = 8;
#define PHASE_BEGIN(n) if (ph_lo <= (n) && (n) < ph_hi) { int g_tid = threadIdx.x, g_bid = blockIdx.x; asm volatile("" : "+v"(g_tid)); asm volatile("" : "+s"(g_bid));
#define PHASE_END(n) if ((n) + 1 < ph_hi) xcd_barrier(xb); }
__global__ void __launch_bounds__(256, 2) mega(Params p, int ph_lo, int ph_hi) {
  __shared__ __attribute__((aligned(16))) char smem[3 * G_STAGE + 64];
  __shared__ uint4 xb_words;
  cg::grid_group grid = cg::this_grid();
  if (ph_hi < 0) grid.sync();
  if (threadIdx.x == 0) xb_words = make_uint4(0u, 0u, 0u, 0u);
  __syncthreads();
  XcdBarrier xb = xcd_barrier_post(p.bar, (volatile LAS unsigned*)&xb_words);
  PHASE_BEGIN(0) phase_prepass(p, smem, g_tid, g_bid); PHASE_END(0)
  PHASE_BEGIN(1)
    {
      const int xcd = g_bid & 7, loc = g_bid >> 3, nloc = gridDim.x >> 3;
      const int nr1 = (272 + nloc - 1) / nloc; const bool stag = loc >= (nloc >> 1);
      for (int r = 0; r < nr1; ++r) {
        const int rr = stag ? (r + 3) % nr1 : r;
        const int j = loc + rr * nloc;
        if (j >= 272) continue;
        if (j < 192) gemm_tile<0, 8>(p, 0, xcd * 8 + (j & 7), j >> 3, smem, g_tid);
        else if (j < 256) { int jj = 192 + ((j - 192) >> 1), hf = j & 1; gemm_tile<0, 4>(p, 0, (xcd * 8 + (jj & 7)) * 2 + hf, jj >> 3, smem, g_tid); }
        else { int u = xcd * 16 + (j - 256); int layer = u >> 6, r = u & 63; gemm_tile<1, 4>(p, layer, r >> 2, r & 3, smem, g_tid); }
      }
    }
  PHASE_END(1)
  PHASE_BEGIN(2) phase_attn(p, 0, smem, g_tid, g_bid); PHASE_END(2)
  PHASE_BEGIN(3)
    {
      const int xcd = g_bid & 7, loc = g_bid >> 3, nloc = gridDim.x >> 3;
      for (int j = loc; j < 64; j += nloc) gemm_tile<2, 8>(p, 0, xcd * 8 + (j & 7), j >> 3, smem, g_tid);
    }
  PHASE_END(3)
  PHASE_BEGIN(4)
    {
      const int xcd = g_bid & 7, loc = g_bid >> 3, nloc = gridDim.x >> 3;
      const int nr4 = (256 + nloc - 1) / nloc; const bool stag = loc >= (nloc >> 1);
      for (int r = 0; r < nr4; ++r) {
        const int rr = stag ? (r + nr4 - 1) % nr4 : r;
        const int j = loc + rr * nloc;
        if (j >= 256) continue;
        if (j < 192) gemm_tile<0, 8>(p, 1, xcd * 8 + (j & 7), j >> 3, smem, g_tid);
        else { int jj = 192 + ((j - 192) >> 1), hf = j & 1; gemm_tile<0, 4>(p, 1, (xcd * 8 + (jj & 7)) * 2 + hf, jj >> 3, smem, g_tid); }
      }
    }
  PHASE_END(4)
  PHASE_BEGIN(5) phase_attn(p, 1, smem, g_tid, g_bid); PHASE_END(5)
  PHASE_BEGIN(6)
    {
      const int xcd = g_bid & 7, loc = g_bid >> 3, nloc = gridDim.x >> 3;
      for (int j = loc; j < 64; j += nloc) gemm_tile<2, 8>(p, 1, xcd * 8 + (j & 7), j >> 3, smem, g_tid);
    }
  PHASE_END(6)
  PHASE_BEGIN(7) phase_final(p, g_tid, g_bid); PHASE_END(7)
}

extern "C" void kernel_launch(void* const* d_in, const int* in_sizes, int n_in, void* d_out, int out_size, void* d_ws, size_t ws_size,
                              hipStream_t stream) {
  Params p{};
  p.x = (const float*)d_in[0]; p.mem = (const float*)d_in[1]; p.norm_g = (const float*)d_in[2]; p.w_in = (const float*)d_in[3];
  p.mem_norm_g = (const float*)d_in[4]; p.w_mem_kv = (const float*)d_in[5]; p.w_out = (const float*)d_in[6];
  p.final_g = (const float*)d_in[7];
  p.out = (float*)d_out;
  char* ws = (char*)d_ws;
  p.xb = (bf16_t*)(ws + 0);
  p.proj = (bf16_t*)(ws + 33554432ull);
  p.mixed = (bf16_t*)(ws + 150994944ull);
  p.wTin = (bf16_t*)(ws + 184549376ull);
  p.wTkv = (bf16_t*)(ws + 199229440ull);
  p.wTout = (bf16_t*)(ws + 201326592ull);
  p.memb = (bf16_t*)(ws + 205520896ull);
  p.mkv = (bf16_t*)(ws + 209715200ull);
  p.ss = (float*)(ws + 213909504ull);
  p.memss = (float*)(ws + 214106112ull);
  p.kmean = (float*)(ws + 214114304ull);
  p.costab = (float*)(ws + 214310912ull);
  p.sintab = (float*)(ws + 214376448ull);
  p.sbvT = (bf16_t*)(ws + 214441984ull);
  p.mbvT = (bf16_t*)(ws + 227024896ull);
  p.mvT = (bf16_t*)(ws + 239607808ull);
  p.bar = (unsigned*)(ws + 241704960ull);

  static int grid_blocks = 0;
  if (!grid_blocks) {
    int dev = 0, cus = 0, per_cu = 0;
    (void)hipGetDevice(&dev);
    (void)hipDeviceGetAttribute(&cus, hipDeviceAttributeMultiprocessorCount, dev);
    (void)hipOccupancyMaxActiveBlocksPerMultiprocessor(&per_cu, mega, 256, 0);
    if (per_cu > 2) per_cu = 2;
    if (per_cu < 1) per_cu = 1;
    grid_blocks = cus * per_cu;
  }
#if MULTI_LAUNCH
  for (int ph = 0; ph < NPHASE; ++ph) {
    if (NAIVE_ATTN && (ph == 2 || ph == 5)) {
      int layer = ph == 2 ? 0 : 1;
      hipLaunchKernelGGL(attn_naive_sb, dim3(384), dim3(256), 0, stream, p, layer);
      hipLaunchKernelGGL(attn_naive_moba, dim3(384), dim3(256), 0, stream, p, layer);
      hipLaunchKernelGGL(attn_naive_mem, dim3(256), dim3(256), 0, stream, p, layer);
    } else {
      hipLaunchKernelGGL(mega, dim3(grid_blocks), dim3(256), 0, stream, p, ph, ph + 1);
    }
  }
#else
  int lo = 0, hi = NPHASE;
  (void)hipMemsetAsync(p.bar, 0, (XCD_BAR_WORDS + 64) * sizeof(unsigned), stream);
  void* args[] = {&p, &lo, &hi};
  hipError_t e = hipLaunchCooperativeKernel((void*)mega, dim3(grid_blocks), dim3(256), args, 0, stream);
  if (e != hipSuccess) fprintf(stderr, "cooperative launch failed: %s (grid %d)\n", hipGetErrorString(e), grid_blocks);
#endif
}
```

```cpp
#include <hip/hip_runtime.h>
#include <hip/hip_cooperative_groups.h>
#include <stdint.h>
#include <cstdio>
namespace cg = cooperative_groups;

#ifndef MULTI_LAUNCH
#define MULTI_LAUNCH 0
#endif
#ifndef NAIVE_ATTN
#define NAIVE_ATTN 0
#endif

typedef unsigned short bf16_t;
using bf16x8 = __attribute__((ext_vector_type(8))) short;
using f32x4 = __attribute__((ext_vector_type(4))) float;
using u32x4 = __attribute__((ext_vector_type(4))) unsigned;
#define DI __device__ __forceinline__

constexpr int NB = 8, T = 2048, D = 1024, NTOK = NB * T, INC = 3584, MEML = 256, NMEM = NB * MEML;
constexpr int C_SBQ = 0, C_SBK = 384, C_SBV = 768, C_SBG = 1152, C_MBQ = 1536, C_MBK = 1920, C_MBV = 2304, C_MBG = 2688,
              C_MQ = 3072, C_MG = 3328;

struct Params {
  const float* x; const float* mem; const float* norm_g; const float* w_in; const float* mem_norm_g;
  const float* w_mem_kv; const float* w_out; const float* final_g;
  float* out;
  bf16_t* xb; bf16_t* proj; bf16_t* mixed; bf16_t* wTin; bf16_t* wTkv; bf16_t* wTout; bf16_t* memb; bf16_t* mkv;
  float* ss; float* memss; float* kmean; float* costab; float* sintab;
  bf16_t* sbvT; bf16_t* mbvT; bf16_t* mvT;
  unsigned* bar;
};

DI bf16_t f2bf(float x) { unsigned u = __float_as_uint(x); u += 0x7fffu + ((u >> 16) & 1u); return (bf16_t)(u >> 16); }
DI float bf2f(bf16_t b) { return __uint_as_float(((unsigned)b) << 16); }
DI float bflo(unsigned u) { return __uint_as_float(u << 16); }
DI float bfhi(unsigned u) { return __uint_as_float(u & 0xffff0000u); }
typedef float f32x2_t __attribute__((ext_vector_type(2)));
typedef __bf16 bf16x2_t __attribute__((ext_vector_type(2)));
DI unsigned pack2(float a, float b) { f32x2_t v = {a, b}; return __builtin_bit_cast(unsigned, __builtin_convertvector(v, bf16x2_t)); }
DI float4 ld_nt4(const float* ptr) { f32x4 t = __builtin_nontemporal_load((const f32x4*)ptr); return float4{t[0], t[1], t[2], t[3]}; }
DI float shfl16(float x) {
  const unsigned u = __float_as_uint(x);
  auto r = __builtin_amdgcn_permlane16_swap(u, u, false, false);
  return __uint_as_float((r[0] == u) ? r[1] : r[0]);
}
DI float shfl32(float x) {
  const unsigned u = __float_as_uint(x);
  auto r = __builtin_amdgcn_permlane32_swap(u, u, false, false);
  return __uint_as_float((r[0] == u) ? r[1] : r[0]);
}
DI float wave_sum(float v) {
#pragma unroll
  for (int o = 32; o >= 1; o >>= 1) v += __shfl_xor(v, o);
  return v;
}

DI void transpose_tile(const float* __restrict__ src, const float* __restrict__ g, bf16_t* __restrict__ dst, int N, int kt, int nt,
                       float* tile, int g_tid) {
  const int tid = g_tid;
  __syncthreads();
#pragma unroll
  for (int pss = 0; pss < 4; ++pss) {
    int kr = pss * 16 + (tid >> 4), nc = (tid & 15) * 4;
    int k = kt * 64 + kr;
    float4 v = ld_nt4(src + (size_t)k * N + nt * 64 + nc);
    float gs = g ? g[k] : 1.f;
    tile[kr * 65 + nc + 0] = v.x * gs; tile[kr * 65 + nc + 1] = v.y * gs;
    tile[kr * 65 + nc + 2] = v.z * gs; tile[kr * 65 + nc + 3] = v.w * gs;
  }
  __syncthreads();
#pragma unroll
  for (int pss = 0; pss < 2; ++pss) {
    int nr = pss * 32 + (tid >> 3), kc = (tid & 7) * 8;
    uint4 o;
    o.x = pack2(tile[(kc + 0) * 65 + nr], tile[(kc + 1) * 65 + nr]);
    o.y = pack2(tile[(kc + 2) * 65 + nr], tile[(kc + 3) * 65 + nr]);
    o.z = pack2(tile[(kc + 4) * 65 + nr], tile[(kc + 5) * 65 + nr]);
    o.w = pack2(tile[(kc + 6) * 65 + nr], tile[(kc + 7) * 65 + nr]);
    *(uint4*)(dst + (size_t)(nt * 64 + nr) * 1024 + kt * 64 + kc) = o;
  }
}

DI void row_convert(const float* __restrict__ src, bf16_t* __restrict__ dst, float* __restrict__ ssout, int row, int lane) {
  const float* r = src + (size_t)row * 1024;
  float s = 0.f;
#pragma unroll
  for (int i = 0; i < 2; ++i) {
    int c = i * 512 + lane * 8;
    float4 a = *(const float4*)(r + c), b = *(const float4*)(r + c + 4);
    s += a.x * a.x + a.y * a.y + a.z * a.z + a.w * a.w + b.x * b.x + b.y * b.y + b.z * b.z + b.w * b.w;
    uint4 o; o.x = pack2(a.x, a.y); o.y = pack2(a.z, a.w); o.z = pack2(b.x, b.y); o.w = pack2(b.z, b.w);
    *(uint4*)(dst + (size_t)row * 1024 + c) = o;
  }
  s = wave_sum(s);
  if (lane == 0) ssout[row] = s;
}

DI void phase_prepass(const Params& p, char* smem, int g_tid, int g_bid) {
  const int tid = g_tid, lane = tid & 63, wid = tid >> 6;
  const int gtid = g_bid * 256 + tid, gth = gridDim.x * 256;
  for (int i = gtid; i < 2 * 8 * 8 * 384; i += gth) p.kmean[i] = 0.f;
  for (int i = gtid; i < 2 * NTOK; i += gth) p.ss[NTOK + i] = 0.f;
  for (int i = gtid; i < T * 8; i += gth) {
    int pos = i >> 3, f = i & 7;
    const float invf[8] = {1.000000000e+00f, 1.939227447e-01f, 3.760603093e-02f, 7.292664737e-03f, 1.414213562e-03f, 2.742481757e-04f, 5.318295897e-05f, 1.031338538e-05f};
    float inv = invf[0];
#pragma unroll
    for (int q = 1; q < 8; ++q) inv = (f == q) ? invf[q] : inv;
    float ang = (float)pos * inv;
    p.costab[i] = cosf(ang); p.sintab[i] = sinf(ang);
  }
  const int NT_IN = 16 * 56, NT_KV = 16 * 8, NT_OUT = 16 * 16;
  const int per_layer = NT_IN + NT_KV + NT_OUT;
  for (int job = g_bid; job < 2 * per_layer; job += gridDim.x) {
    int layer = job / per_layer, j = job % per_layer;
    if (j < NT_IN) {
      transpose_tile(p.w_in + (size_t)layer * 1024 * INC, p.norm_g + layer * 1024, p.wTin + (size_t)layer * INC * 1024, INC, j / 56, j % 56,
                     (float*)smem, g_tid);
    } else if (j < NT_IN + NT_KV) {
      j -= NT_IN;
      transpose_tile(p.w_mem_kv + (size_t)layer * 1024 * 512, p.mem_norm_g + layer * 1024, p.wTkv + (size_t)layer * 512 * 1024, 512, j / 8,
                     j % 8, (float*)smem, g_tid);
    } else {
      j -= NT_IN + NT_KV;
      transpose_tile(p.w_out + (size_t)layer * 1024 * 1024, nullptr, p.wTout + (size_t)layer * 1024 * 1024, 1024, j / 16, j % 16,
                     (float*)smem, g_tid);
    }
  }
  {
    const int stride = gridDim.x * 4;
    for (int r0 = g_bid * 4 + wid; r0 < NTOK + NMEM; r0 += 3 * stride) {
      float4 va[3][4];
#pragma unroll
      for (int u = 0; u < 3; ++u) {
        const int r = r0 + u * stride;
        if (r < NTOK + NMEM) {
          const float* rp = (r < NTOK) ? p.x + (size_t)r * 1024 : p.mem + (size_t)(r - NTOK) * 1024;
#pragma unroll
          for (int i = 0; i < 2; ++i) { va[u][2 * i] = ld_nt4(rp + i * 512 + lane * 8); va[u][2 * i + 1] = ld_nt4(rp + i * 512 + lane * 8 + 4); }
        }
      }
#pragma unroll
      for (int u = 0; u < 3; ++u) {
        const int r = r0 + u * stride;
        if (r < NTOK + NMEM) {
          bf16_t* dp = (r < NTOK) ? p.xb + (size_t)r * 1024 : p.memb + (size_t)(r - NTOK) * 1024;
          float sacc = 0.f;
#pragma unroll
          for (int i = 0; i < 2; ++i) {
            const float4 a = va[u][2 * i], b = va[u][2 * i + 1];
            sacc += a.x * a.x + a.y * a.y + a.z * a.z + a.w * a.w + b.x * b.x + b.y * b.y + b.z * b.z + b.w * b.w;
            uint4 o; o.x = pack2(a.x, a.y); o.y = pack2(a.z, a.w); o.z = pack2(b.x, b.y); o.w = pack2(b.z, b.w);
            *(uint4*)(dp + i * 512 + lane * 8) = o;
          }
          sacc = wave_sum(sacc);
          if (lane == 0) { if (r < NTOK) p.ss[r] = sacc; else p.memss[r - NTOK] = sacc; }
        }
      }
    }
  }
}

constexpr int LDS_STR = 72;
constexpr int G_STAGE = (256 + 128) * 64;

template <int MODE, int MT>
DI void gemm_tile(const Params& p, int layer, int mt, int nt, char* smem, int g_tid) {
  const int tid = g_tid, lane = tid & 63, wid = tid >> 6, wr = wid >> 1, wc = wid & 1;
  const int fr = lane & 15, fq = lane >> 4;
  const bf16_t* A; const bf16_t* Bt;
  if (MODE == 0) { A = p.xb; Bt = p.wTin + (size_t)layer * INC * 1024; }
  else if (MODE == 1) { A = p.memb; Bt = p.wTkv + (size_t)layer * 512 * 1024; }
  else { A = p.mixed; Bt = p.wTout + (size_t)layer * 1024 * 1024; }
  const bf16_t* Ag = A + (size_t)(mt * (MT * 32)) * 1024;
  const bf16_t* Bg = Bt + (size_t)(nt * 128) * 1024;
  f32x4 acc[MT][4];
#pragma unroll
  for (int m = 0; m < MT; ++m)
#pragma unroll
    for (int n = 0; n < 4; ++n) acc[m][n] = f32x4{0.f, 0.f, 0.f, 0.f};
  constexpr int NLD = (MT == 8) ? 6 : 4;
  u32x4 rgA[NLD], rgB[NLD];
  const unsigned goff0 = (unsigned)((tid >> 2) * 2048 + (((tid & 3) ^ (((tid >> 5) & 1) * 3)) * 16));
  const int sbase = tid * 16;
  const char* Ab = (const char*)Ag; const char* Bb = (const char*)Bg;
#define G_LOAD(R, KT) _Pragma("unroll") for (int i = 0; i < NLD; ++i) { \
    const int ii = (MT == 8) ? i : (i < 2 ? i : i + 2); \
    const char* gb = ((ii < 4) ? Ab + ii * 131072 : Bb + (ii - 4) * 131072) + (KT) * 64; \
    R[i] = *(const u32x4*)(gb + goff0); }
#define G_STORE(R, ST) _Pragma("unroll") for (int i = 0; i < NLD; ++i) { \
    const int ii = (MT == 8) ? i : (i < 2 ? i : i + 2); \
    *(u32x4*)((ST) + ii * 4096 + sbase) = R[i]; }
#define G_COMPUTE(ST) { const char* st = (ST); bf16x8 b[4]; \
    _Pragma("unroll") for (int n = 0; n < 4; ++n) b[n] = *(const bf16x8*)(st + boff + (n >> 1) * 2048 + (n & 1) * 256); \
    _Pragma("unroll") for (int mh = 0; mh < MT; mh += 4) { bf16x8 a[4]; \
      _Pragma("unroll") for (int m = 0; m < 4; ++m) a[m] = *(const bf16x8*)(st + aoff + (mh + m) * 1024); \
      __builtin_amdgcn_s_setprio(1); \
      _Pragma("unroll") for (int m = 0; m < 4; ++m) \
        _Pragma("unroll") for (int n = 0; n < 4; ++n) acc[mh + m][n] = __builtin_amdgcn_mfma_f32_16x16x32_bf16(b[n], a[m], acc[mh + m][n], 0, 0, 0); \
      __builtin_amdgcn_s_setprio(0); } }
  const int aoff = (wr * (MT * 16) + fr) * 64 + ((fq ^ (((fr >> 3) & 1) * 3)) & 3) * 16;
  const int boff = 16384 + (wc * 64 + 8 * (fr >> 2) + (fr & 3)) * 64 + ((fq ^ (((fr >> 2) & 1) * 3)) & 3) * 16;
  G_LOAD(rgA, 0)
  G_STORE(rgA, smem)
  G_LOAD(rgA, 1)
  G_LOAD(rgB, 2)
#pragma unroll 1
  for (int kt = 0; kt < 32; kt += 2) {
    __syncthreads();
    G_STORE(rgA, smem + G_STAGE)
    if (kt + 3 < 32) G_LOAD(rgA, kt + 3)
    G_COMPUTE(smem)
    __syncthreads();
    if (kt + 2 < 32) G_STORE(rgB, smem)
    if (kt + 4 < 32) G_LOAD(rgB, kt + 4)
    G_COMPUTE(smem + G_STAGE)
  }
#undef G_LOAD
#undef G_STORE
#undef G_COMPUTE
  const int cb = nt * 128 + wc * 64;
  const int rb0 = mt * (MT * 32) + wr * (MT * 16);
  if (MODE == 0) {
    const bool rot = (cb >= C_MBQ && cb < C_MBV);
    const bool km = (cb >= C_MBK && cb < C_MBV);
    f32x4 colsum[4];
#pragma unroll
    for (int n = 0; n < 4; ++n) colsum[n] = f32x4{0.f, 0.f, 0.f, 0.f};
    float rsv[MT];
#pragma unroll
    for (int m = 0; m < MT; ++m) rsv[m] = p.ss[layer * NTOK + rb0 + m * 16 + fr];
#pragma unroll
    for (int m = 0; m < MT; ++m) rsv[m] = rsqrtf(rsv[m] * (1.f / 1024.f) + 1e-6f);
#pragma unroll
    for (int m = 0; m < MT; ++m) {
      const int grow = rb0 + m * 16 + fr;
      const float rs = rsv[m];
#pragma unroll
      for (int pp = 0; pp < 2; ++pp) {
        f32x4 v0 = acc[m][2 * pp] * rs, v1 = acc[m][2 * pp + 1] * rs;
        if (pp == 0 && rot) {
          const int pos = grow & (T - 1);
          const float4 c0 = *(const float4*)(p.costab + pos * 8), c1 = *(const float4*)(p.costab + pos * 8 + 4);
          const float4 s0 = *(const float4*)(p.sintab + pos * 8), s1 = *(const float4*)(p.sintab + pos * 8 + 4);
          const float cc[8] = {c0.x, c0.y, c0.z, c0.w, c1.x, c1.y, c1.z, c1.w};
          const float sn[8] = {s0.x, s0.y, s0.z, s0.w, s1.x, s1.y, s1.z, s1.w};
#pragma unroll
          for (int j = 0; j < 4; ++j) {
            const float p0 = shfl16(v0[j]), p1 = shfl16(v1[j]);
            const float r0 = (fq == 0) ? (v0[j] * cc[j] - p0 * sn[j]) : (v0[j] * cc[j] + p0 * sn[j]);
            const float r1 = (fq == 0) ? (v1[j] * cc[4 + j] - p1 * sn[4 + j]) : (v1[j] * cc[4 + j] + p1 * sn[4 + j]);
            v0[j] = (fq < 2) ? r0 : v0[j];
            v1[j] = (fq < 2) ? r1 : v1[j];
          }
        }
        if (km) { colsum[2 * pp] += v0; colsum[2 * pp + 1] += v1; }
        uint4 o; o.x = pack2(v0[0], v0[1]); o.y = pack2(v0[2], v0[3]); o.z = pack2(v1[0], v1[1]); o.w = pack2(v1[2], v1[3]);
        *(uint4*)(p.proj + (size_t)grow * INC + cb + pp * 32 + fq * 8) = o;
      }
      if (m & 1) asm volatile("" ::: "memory");
    }
    if (km) {
      const int b = rb0 / T, blk = (rb0 % T) / 256;
#pragma unroll
      for (int n = 0; n < 4; ++n)
#pragma unroll
        for (int j = 0; j < 4; ++j) {
          float sm = colsum[n][j];
          sm += __shfl_xor(sm, 1); sm += __shfl_xor(sm, 2); sm += __shfl_xor(sm, 4); sm += __shfl_xor(sm, 8);
          if (fr == 0) atomicAdd(&p.kmean[((layer * 8 + b) * 8 + blk) * 384 + (cb - C_MBK) + (n >> 1) * 32 + fq * 8 + (n & 1) * 4 + j], sm);
        }
    }
  } else if (MODE == 1) {
    float rsv[MT];
#pragma unroll
    for (int m = 0; m < MT; ++m) rsv[m] = p.memss[rb0 + m * 16 + fr];
#pragma unroll
    for (int m = 0; m < MT; ++m) rsv[m] = rsqrtf(rsv[m] * (1.f / 1024.f) + 1e-6f);
#pragma unroll
    for (int m = 0; m < MT; ++m) {
      const int grow = rb0 + m * 16 + fr;
#pragma unroll
      for (int pp = 0; pp < 2; ++pp) {
        f32x4 v0 = acc[m][2 * pp] * rsv[m], v1 = acc[m][2 * pp + 1] * rsv[m];
        uint4 o; o.x = pack2(v0[0], v0[1]); o.y = pack2(v0[2], v0[3]); o.z = pack2(v1[0], v1[1]); o.w = pack2(v1[2], v1[3]);
        *(uint4*)(p.mkv + (size_t)layer * NMEM * 512 + (size_t)grow * 512 + cb + pp * 32 + fq * 8) = o;
      }
      if (m & 1) asm volatile("" ::: "memory");
    }
  } else {
    if (layer == 0) {
#pragma unroll
      for (int mp = 0; mp < MT / 2; ++mp) {
        uint4 xo[2][2];
#pragma unroll
        for (int h2 = 0; h2 < 2; ++h2)
#pragma unroll
          for (int pp = 0; pp < 2; ++pp)
            xo[h2][pp] = *(const uint4*)(p.xb + (size_t)(rb0 + (mp * 2 + h2) * 16 + fr) * 1024 + cb + pp * 32 + fq * 8);
#pragma unroll
        for (int h2 = 0; h2 < 2; ++h2) {
          const int m = mp * 2 + h2;
          const int grow = rb0 + m * 16 + fr;
          float sq = 0.f;
#pragma unroll
          for (int pp = 0; pp < 2; ++pp) {
            const size_t idx = (size_t)grow * 1024 + cb + pp * 32 + fq * 8;
            const uint4 u = xo[h2][pp];
            float4 xa, xc;
            xa.x = bflo(u.x) + acc[m][2 * pp][0]; xa.y = bfhi(u.x) + acc[m][2 * pp][1];
            xa.z = bflo(u.y) + acc[m][2 * pp][2]; xa.w = bfhi(u.y) + acc[m][2 * pp][3];
            xc.x = bflo(u.z) + acc[m][2 * pp + 1][0]; xc.y = bfhi(u.z) + acc[m][2 * pp + 1][1];
            xc.z = bflo(u.w) + acc[m][2 * pp + 1][2]; xc.w = bfhi(u.w) + acc[m][2 * pp + 1][3];
            uint4 o; o.x = pack2(xa.x, xa.y); o.y = pack2(xa.z, xa.w); o.z = pack2(xc.x, xc.y); o.w = pack2(xc.z, xc.w);
            *(uint4*)(p.xb + idx) = o;
            sq += xa.x * xa.x + xa.y * xa.y + xa.z * xa.z + xa.w * xa.w + xc.x * xc.x + xc.y * xc.y + xc.z * xc.z + xc.w * xc.w;
          }
          sq += shfl16(sq); sq += shfl32(sq);
          if (fq == 0) atomicAdd(&p.ss[NTOK + grow], sq);
        }
        asm volatile("" ::: "memory");
      }
    } else {
#pragma unroll
      for (int mp = 0; mp < MT / 2; ++mp) {
        uint4 xo[2][2];
#pragma unroll
        for (int h2 = 0; h2 < 2; ++h2)
#pragma unroll
          for (int pp = 0; pp < 2; ++pp)
            xo[h2][pp] = *(const uint4*)(p.xb + (size_t)(rb0 + (mp * 2 + h2) * 16 + fr) * 1024 + cb + pp * 32 + fq * 8);
#pragma unroll
        for (int h2 = 0; h2 < 2; ++h2) {
          const int m = mp * 2 + h2;
          const int grow = rb0 + m * 16 + fr;
          float sq = 0.f;
#pragma unroll
          for (int pp = 0; pp < 2; ++pp) {
            const size_t idx = (size_t)grow * 1024 + cb + pp * 32 + fq * 8;
            const uint4 u = xo[h2][pp];
            float4 xa, xc;
            xa.x = bflo(u.x) + acc[m][2 * pp][0]; xa.y = bfhi(u.x) + acc[m][2 * pp][1];
            xa.z = bflo(u.y) + acc[m][2 * pp][2]; xa.w = bfhi(u.y) + acc[m][2 * pp][3];
            xc.x = bflo(u.z) + acc[m][2 * pp + 1][0]; xc.y = bfhi(u.z) + acc[m][2 * pp + 1][1];
            xc.z = bflo(u.w) + acc[m][2 * pp + 1][2]; xc.w = bfhi(u.w) + acc[m][2 * pp + 1][3];
            { uint4 o; o.x = pack2(xa.x, xa.y); o.y = pack2(xa.z, xa.w); o.z = pack2(xc.x, xc.y); o.w = pack2(xc.z, xc.w);
              *(uint4*)(p.xb + idx) = o; }
            sq += xa.x * xa.x + xa.y * xa.y + xa.z * xa.z + xa.w * xa.w + xc.x * xc.x + xc.y * xc.y + xc.z * xc.z + xc.w * xc.w;
          }
          sq += shfl16(sq); sq += shfl32(sq);
          if (fq == 0) atomicAdd(&p.ss[2 * NTOK + grow], sq);
        }
        asm volatile("" ::: "memory");
      }
    }
  }
}

DI void load_row64(const bf16_t* __restrict__ ptr, float (&r)[64], float scale) {
#pragma unroll
  for (int i = 0; i < 8; ++i) {
    uint4 u = *(const uint4*)(ptr + i * 8);
    r[i * 8 + 0] = bflo(u.x) * scale; r[i * 8 + 1] = bfhi(u.x) * scale;
    r[i * 8 + 2] = bflo(u.y) * scale; r[i * 8 + 3] = bfhi(u.y) * scale;
    r[i * 8 + 4] = bflo(u.z) * scale; r[i * 8 + 5] = bfhi(u.z) * scale;
    r[i * 8 + 6] = bflo(u.w) * scale; r[i * 8 + 7] = bfhi(u.w) * scale;
  }
}
DI float dot_row64(const bf16_t* __restrict__ ptr, const float (&q)[64]) {
  float z = 0.f;
#pragma unroll
  for (int i = 0; i < 8; ++i) {
    uint4 u = *(const uint4*)(ptr + i * 8);
    z += q[i * 8 + 0] * bflo(u.x); z += q[i * 8 + 1] * bfhi(u.x);
    z += q[i * 8 + 2] * bflo(u.y); z += q[i * 8 + 3] * bfhi(u.y);
    z += q[i * 8 + 4] * bflo(u.z); z += q[i * 8 + 5] * bfhi(u.z);
    z += q[i * 8 + 6] * bflo(u.w); z += q[i * 8 + 7] * bfhi(u.w);
  }
  return z;
}
DI void axpy_row64(const bf16_t* __restrict__ ptr, float w, float (&acc)[64]) {
#pragma unroll
  for (int i = 0; i < 8; ++i) {
    uint4 u = *(const uint4*)(ptr + i * 8);
    acc[i * 8 + 0] += w * bflo(u.x); acc[i * 8 + 1] += w * bfhi(u.x);
    acc[i * 8 + 2] += w * bflo(u.y); acc[i * 8 + 3] += w * bfhi(u.y);
    acc[i * 8 + 4] += w * bflo(u.z); acc[i * 8 + 5] += w * bfhi(u.z);
    acc[i * 8 + 6] += w * bflo(u.w); acc[i * 8 + 7] += w * bfhi(u.w);
  }
}
DI void gate_store(const bf16_t* __restrict__ gp, bf16_t* __restrict__ op, const float (&acc)[64], float scale) {
#pragma unroll
  for (int i = 0; i < 8; ++i) {
    uint4 u = *(const uint4*)(gp + i * 8);
    float g[8] = {bflo(u.x), bfhi(u.x), bflo(u.y), bfhi(u.y), bflo(u.z), bfhi(u.z), bflo(u.w), bfhi(u.w)};
    float o[8];
#pragma unroll
    for (int e = 0; e < 8; ++e) o[e] = acc[i * 8 + e] * scale * (g[e] / (1.f + __expf(-g[e])));
    uint4 w; w.x = pack2(o[0], o[1]); w.y = pack2(o[2], o[3]); w.z = pack2(o[4], o[5]); w.w = pack2(o[6], o[7]);
    *(uint4*)(op + i * 8) = w;
  }
}

DI void sb_naive_wave(const Params& p, int layer, int item, int lane) {
  const int qc = 31 - (item & 31), bh = item >> 5, h = bh % 6, b = bh / 6;
  const int t = qc * 64 + lane;
  const bf16_t* base = p.proj + (size_t)(b * T) * INC;
  float q[64], acc[64];
  load_row64(base + (size_t)t * INC + C_SBQ + h * 64, q, 0.125f);
#pragma unroll
  for (int d = 0; d < 64; ++d) acc[d] = 0.f;
  float carry = 0.f;
  for (int s = qc * 64 + 62; s >= 0; --s) {
    const bf16_t* kp = base + (size_t)s * INC + C_SBK + h * 64;
    float z = dot_row64(kp, q);
    bool act = s < t;
    float lb = fminf(z, 0.f) - log1pf(expf(-fabsf(z)));
    float w = act ? expf(lb + carry) : 0.f;
    carry += act ? (lb - z) : 0.f;
    axpy_row64(kp + (C_SBV - C_SBK), w, acc);
  }
  gate_store(base + (size_t)t * INC + C_SBG + h * 64, p.mixed + (size_t)(b * T + t) * 1024 + h * 64, acc, 1.f);
}

DI void os_step(const float (&q)[64], float& m, float& l, float (&acc)[64], const bf16_t* kp, const bf16_t* vp, bool valid) {
  float sc = dot_row64(kp, q);
  sc = valid ? sc : -1e30f;
  float mn = fmaxf(m, sc);
  float alpha = __expf(m - mn);
  float pw = valid ? __expf(sc - mn) : 0.f;
  l = l * alpha + pw;
  m = mn;
#pragma unroll
  for (int d = 0; d < 64; ++d) acc[d] *= alpha;
  axpy_row64(vp, pw, acc);
}

DI void moba_naive_wave(const Params& p, int layer, int item, int lane) {
  const int qc = 31 - (item & 31), bh = item >> 5, h = bh % 6, b = bh / 6;
  const int t = qc * 64 + lane, own = qc >> 2;
  const bf16_t* base = p.proj + (size_t)(b * T) * INC;
  float q[64], acc[64];
  load_row64(base + (size_t)t * INC + C_MBQ + h * 64, q, 1.f);
  unsigned sel = 0;
  if (own <= 3) sel = (1u << own) - 1u;
  else {
    float gate[8];
#pragma unroll
    for (int j = 0; j < 8; ++j) {
      float gsum = 0.f;
      if (j < own) {
        const float* km = p.kmean + ((layer * 8 + b) * 8 + j) * 384 + h * 64;
#pragma unroll
        for (int d = 0; d < 64; ++d) gsum += q[d] * km[d];
      }
      gate[j] = gsum;
    }
#pragma unroll
    for (int r = 0; r < 3; ++r) {
      float best = -3.0e38f; int bi = 0;
#pragma unroll
      for (int j = 0; j < 8; ++j) {
        bool ok = (j < own) && !((sel >> j) & 1u) && (gate[j] > best);
        best = ok ? gate[j] : best; bi = ok ? j : bi;
      }
      sel |= 1u << bi;
    }
  }
#pragma unroll
  for (int d = 0; d < 64; ++d) { acc[d] = 0.f; q[d] *= 0.125f; }
  float m = -1e30f, l = 0.f;
  for (int j = 0; j < own; ++j) {
    bool v = (sel >> j) & 1u;
    if (__ballot(v) == 0ull) continue;
    for (int s = j * 256; s < j * 256 + 256; ++s) {
      const bf16_t* kp = base + (size_t)s * INC + C_MBK + h * 64;
      os_step(q, m, l, acc, kp, kp + (C_MBV - C_MBK), v);
    }
  }
  for (int s = own * 256; s <= qc * 64 + 63; ++s) {
    const bf16_t* kp = base + (size_t)s * INC + C_MBK + h * 64;
    os_step(q, m, l, acc, kp, kp + (C_MBV - C_MBK), s <= t);
  }
  gate_store(base + (size_t)t * INC + C_MBG + h * 64, p.mixed + (size_t)(b * T + t) * 1024 + 384 + h * 64, acc, 1.f / l);
}

DI void mem_naive_wave(const Params& p, int layer, int item, int lane) {
  const int qc = item & 31, bh = item >> 5, h = bh & 3, b = bh >> 2;
  const int t = qc * 64 + lane;
  const bf16_t* base = p.proj + (size_t)(b * T) * INC;
  float q[64], acc[64];
  load_row64(base + (size_t)t * INC + C_MQ + h * 64, q, 0.125f);
#pragma unroll
  for (int d = 0; d < 64; ++d) acc[d] = 0.f;
  float m = -1e30f, l = 0.f;
  const bf16_t* kv = p.mkv + (size_t)layer * NMEM * 512 + (size_t)(b * MEML) * 512 + h * 64;
  for (int s = 0; s < MEML; ++s) os_step(q, m, l, acc, kv + (size_t)s * 512, kv + (size_t)s * 512 + 256, true);
  gate_store(base + (size_t)t * INC + C_MG + h * 64, p.mixed + (size_t)(b * T + t) * 1024 + 768 + h * 64, acc, 1.f / l);
}

__global__ void __launch_bounds__(256) attn_naive_sb(Params p, int layer) {
  sb_naive_wave(p, layer, blockIdx.x * 4 + (threadIdx.x >> 6), threadIdx.x & 63);
}
__global__ void __launch_bounds__(256) attn_naive_moba(Params p, int layer) {
  moba_naive_wave(p, layer, blockIdx.x * 4 + (threadIdx.x >> 6), threadIdx.x & 63);
}
__global__ void __launch_bounds__(256) attn_naive_mem(Params p, int layer) {
  mem_naive_wave(p, layer, blockIdx.x * 4 + (threadIdx.x >> 6), threadIdx.x & 63);
}

constexpr int AT_STR = 72;
constexpr float C2 = 0.125f * 1.4426950408889634f;

DI bf16x8 pack8(const f32x4& a, const f32x4& b) {
  u32x4 r;
  r[0] = pack2(a[0], a[1]); r[1] = pack2(a[2], a[3]); r[2] = pack2(b[0], b[1]); r[3] = pack2(b[2], b[3]);
  return __builtin_bit_cast(bf16x8, r);
}

struct TileSrc { const bf16_t* k; int kstride; const bf16_t* v; };

DI void tile_gload(const TileSrc& ts, int k0, int tid, u32x4 (&rk)[2], u32x4 (&rv)[2]) {
  const unsigned toff = (unsigned)((tid >> 3) * ts.kstride * 2 + (tid & 7) * 16);
#pragma unroll
  for (int i = 0; i < 2; ++i) {
    const char* kb = (const char*)ts.k + (size_t)(k0 + 32 * i) * ts.kstride * 2;
    const char* vb = (const char*)ts.v + (size_t)(k0 + 32 * i) * ts.kstride * 2;
    rk[i] = *(const u32x4*)(kb + toff);
    rv[i] = *(const u32x4*)(vb + toff);
  }
}
DI void tile_sstore(bf16_t* Ks, bf16_t* Vs, int tid, const u32x4 (&rk)[2], const u32x4 (&rv)[2]) {
#pragma unroll
  for (int i = 0; i < 2; ++i) {
    int c = tid + i * 256, row = c >> 3, ch = c & 7;
    int kk = row & 31;
    int rho = (row & 32) + ((kk >> 2) & 1) * 16 + (kk >> 3) * 4 + (kk & 3);
    *(u32x4*)(Ks + rho * AT_STR + ch * 8) = rk[i];
    *(u32x4*)(Vs + row * AT_STR + ch * 8) = rv[i];
  }
}

DI void st_mfma(const bf16_t* Ks, const bf16x8 (&qf)[2], f32x4 (&s)[4], int fr, int fq) {
#pragma unroll
  for (int i = 0; i < 4; ++i) {
    bf16x8 a0 = *(const bf16x8*)(Ks + (i * 16 + fr) * AT_STR + fq * 8);
    bf16x8 a1 = *(const bf16x8*)(Ks + (i * 16 + fr) * AT_STR + 32 + fq * 8);
    f32x4 z = {0.f, 0.f, 0.f, 0.f};
    z = __builtin_amdgcn_mfma_f32_16x16x32_bf16(a0, qf[0], z, 0, 0, 0);
    z = __builtin_amdgcn_mfma_f32_16x16x32_bf16(a1, qf[1], z, 0, 0, 0);
    s[i] = z;
  }
}
typedef short s16x4_t __attribute__((ext_vector_type(4)));
DI void pv_mfma(const bf16_t* Vs, const bf16x8 (&pw)[2][2], f32x4 (&o)[2][4], int fr, int fq) {
  const int q = fr >> 2, pp = fr & 3;
#pragma unroll
  for (int dt = 0; dt < 4; ++dt) {
#pragma unroll
    for (int st = 0; st < 2; ++st) {
      const bf16_t* a0p = Vs + (st * 32 + fq * 8 + q) * AT_STR + dt * 16 + 4 * pp;
      s16x4_t lo = __builtin_amdgcn_ds_read_tr16_b64_v4i16((__attribute__((address_space(3))) s16x4_t*)(a0p));
      s16x4_t hi = __builtin_amdgcn_ds_read_tr16_b64_v4i16((__attribute__((address_space(3))) s16x4_t*)(a0p + 4 * AT_STR));
      bf16x8 a = __builtin_shufflevector(lo, hi, 0, 1, 2, 3, 4, 5, 6, 7);
#pragma unroll
      for (int qg = 0; qg < 2; ++qg) o[qg][dt] = __builtin_amdgcn_mfma_f32_16x16x32_bf16(a, pw[qg][st], o[qg][dt], 0, 0, 0);
    }
  }
}

template <int KIND>
DI void attn_item(const Params& p, int layer, int item, char* smem, int g_tid) {
  const int tid = g_tid, lane = tid & 63, wid = tid >> 6, fr = lane & 15, fq = lane >> 4;
  bf16_t* Ksb[2]; bf16_t* Vsb[2];
  Ksb[0] = (bf16_t*)smem; Vsb[0] = Ksb[0] + 64 * AT_STR; Ksb[1] = Vsb[0] + 64 * AT_STR; Vsb[1] = Ksb[1] + 64 * AT_STR;
  unsigned* sU = (unsigned*)(smem + 4 * 64 * AT_STR * 2);
  int b, h, qt;
  const bf16_t *qbase, *gbase; bf16_t* obase; TileSrc ts;
  if (KIND == 0) {
    qt = 15 - (item & 15); int bh = item >> 4; h = bh % 6; b = bh / 6;
    const bf16_t* pb = p.proj + (size_t)(b * T) * INC;
    qbase = pb + C_SBQ + h * 64; gbase = pb + C_SBG + h * 64; ts.k = pb + C_SBK + h * 64; ts.kstride = INC;
    ts.v = pb + C_SBV + h * 64;
    obase = p.mixed + (size_t)(b * T) * 1024 + h * 64;
  } else if (KIND == 1) {
    qt = 15 - (item & 15); int bh = item >> 4; h = bh % 6; b = bh / 6;
    const bf16_t* pb = p.proj + (size_t)(b * T) * INC;
    qbase = pb + C_MBQ + h * 64; gbase = pb + C_MBG + h * 64; ts.k = pb + C_MBK + h * 64; ts.kstride = INC;
    ts.v = pb + C_MBV + h * 64;
    obase = p.mixed + (size_t)(b * T) * 1024 + 384 + h * 64;
  } else {
    qt = item & 15; int bh = item >> 4; h = bh & 3; b = bh >> 2;
    const bf16_t* pb = p.proj + (size_t)(b * T) * INC;
    qbase = pb + C_MQ + h * 64; gbase = pb + C_MG + h * 64;
    ts.k = p.mkv + (size_t)layer * NMEM * 512 + (size_t)(b * MEML) * 512 + h * 64; ts.kstride = 512;
    ts.v = ts.k + 256;
    obase = p.mixed + (size_t)(b * T) * 1024 + 768 + h * 64;
  }
  const int q0 = qt * 128;
  const int tmin = q0 + wid * 32, tmax = tmin + 31;
  bf16x8 qf[2][2];
#pragma unroll
  for (int qg = 0; qg < 2; ++qg)
#pragma unroll
    for (int ks = 0; ks < 2; ++ks)
      qf[qg][ks] = *(const bf16x8*)(qbase + (size_t)(tmin + qg * 16 + fr) * INC + ks * 32 + fq * 8);

  const int own = q0 >> 8, own_start = own << 8;
  u32x4 rk[2], rv[2], rk2[2], rv2[2];
  tile_gload(ts, KIND == 0 ? ((q0 >> 6) + 1) * 64 : (KIND == 1 ? own_start : 0), tid, rk, rv);
  int ntile; unsigned U = 0; int n_own = 0;
  unsigned sel[2] = {0u, 0u};
  if (KIND == 0) ntile = (q0 >> 6) + 2;
  else if (KIND == 2) ntile = 4;
  else {
    n_own = ((q0 - own_start) >> 6) + 2;
    if (own <= 3) { U = (1u << own) - 1u; sel[0] = sel[1] = U; }
    else {
      f32x4 ga[2];
      ga[0] = f32x4{0.f, 0.f, 0.f, 0.f}; ga[1] = ga[0];
#pragma unroll
      for (int ks = 0; ks < 2; ++ks) {
        float kmv[8];
        const float* kmp = p.kmean + (size_t)((layer * 8 + b) * 8 + (fr & 7)) * 384 + h * 64 + ks * 32 + fq * 8;
        float4 k0v = *(const float4*)kmp, k1v = *(const float4*)(kmp + 4);
        kmv[0] = k0v.x; kmv[1] = k0v.y; kmv[2] = k0v.z; kmv[3] = k0v.w; kmv[4] = k1v.x; kmv[5] = k1v.y; kmv[6] = k1v.z; kmv[7] = k1v.w;
        u32x4 hi, lo;
#pragma unroll
        for (int e = 0; e < 4; ++e) {
          float x0 = (fr < 8) ? kmv[2 * e] : 0.f, x1 = (fr < 8) ? kmv[2 * e + 1] : 0.f;
          bf16_t h0 = f2bf(x0), h1 = f2bf(x1);
          hi[e] = (unsigned)h0 | ((unsigned)h1 << 16);
          lo[e] = pack2(x0 - bf2f(h0), x1 - bf2f(h1));
        }
        bf16x8 ah = __builtin_bit_cast(bf16x8, hi), al = __builtin_bit_cast(bf16x8, lo);
#pragma unroll
        for (int qg = 0; qg < 2; ++qg) {
          ga[qg] = __builtin_amdgcn_mfma_f32_16x16x32_bf16(ah, qf[qg][ks], ga[qg], 0, 0, 0);
          ga[qg] = __builtin_amdgcn_mfma_f32_16x16x32_bf16(al, qf[qg][ks], ga[qg], 0, 0, 0);
        }
      }
#pragma unroll
      for (int qg = 0; qg < 2; ++qg) {
        float gate[8];
#pragma unroll
        for (int j = 0; j < 4; ++j) {
          float mine = ga[qg][j], oth = shfl16(mine);
          gate[j] = (fq & 1) ? oth : mine;
          gate[4 + j] = (fq & 1) ? mine : oth;
        }
        unsigned sl = 0;
#pragma unroll
        for (int r = 0; r < 3; ++r) {
          float best = -3.0e38f; int bi = 0;
#pragma unroll
          for (int j = 0; j < 8; ++j) {
            bool ok = (j < own) && !((sl >> j) & 1u) && (gate[j] > best);
            best = ok ? gate[j] : best; bi = ok ? j : bi;
          }
          sl |= 1u << bi;
        }
        sl = __shfl(sl, lane & 31);
        sel[qg] = sl;
      }
      unsigned u = sel[0] | sel[1];
#pragma unroll
      for (int o = 32; o >= 1; o >>= 1) u |= __shfl_xor(u, o);
      __syncthreads();
      if (tid == 0) *sU = 0u;
      __syncthreads();
      if (lane == 0) atomicOr(sU, u);
      __syncthreads();
      U = *sU;
    }
    ntile = n_own + 4 * __popc(U);
  }
  auto tile_k0 = [&](int i) -> int {
    if (KIND == 0) return (ntile - 1 - i) * 64;
    if (KIND == 2) return i * 64;
    if (i < n_own) return own_start + i * 64;
    int ii = i - n_own, nb = ii >> 2, blk = 0; unsigned u = U;
    for (int c = 0; c < nb; ++c) u &= u - 1;
    blk = __ffs(u) - 1;
    return blk * 256 + (ii & 3) * 64;
  };

  f32x4 o[2][4];
#pragma unroll
  for (int qg = 0; qg < 2; ++qg)
#pragma unroll
    for (int dt = 0; dt < 4; ++dt) o[qg][dt] = f32x4{0.f, 0.f, 0.f, 0.f};
  float carry[2] = {1.f, 1.f};
  float mrun[2] = {-1e30f, -1e30f}, lrun[2] = {0.f, 0.f};

  __syncthreads();
  tile_sstore(Ksb[0], Vsb[0], tid, rk, rv);
  if (ntile > 1) tile_gload(ts, tile_k0(1), tid, rk, rv);
  __syncthreads();
  auto step = [&](const int i, u32x4 (&lk)[2], u32x4 (&lv)[2], const u32x4 (&sk)[2], const u32x4 (&sv2)[2]) -> bool {
    const int k0 = tile_k0(i);
    const bf16_t* Ks = Ksb[i & 1]; const bf16_t* Vs = Vsb[i & 1];
    if (i + 2 < ntile) tile_gload(ts, tile_k0(i + 2), tid, lk, lv);
    bool skip = false, diag = false;
    if (KIND == 0) { skip = (k0 >= tmax); diag = (k0 + 63 >= tmin); }
    if (KIND == 1 && i < n_own) { skip = (k0 > tmax); diag = (k0 + 63 > tmin); }
    if (!skip) {
      bf16x8 pw[2][2];
      if (KIND == 0) {
#pragma unroll
        for (int qg = 0; qg < 2; ++qg) {
          const int t = tmin + qg * 16 + fr;
          f32x4 s[4];
          st_mfma(Ks, qf[qg], s, fr, fq);
          float om[16], be[16];
#pragma unroll
          for (int ii = 0; ii < 4; ++ii)
#pragma unroll
            for (int j = 0; j < 4; ++j) {
              const int e = ii * 4 + j;
              float z2 = fmaxf(s[ii][j] * C2, -100.f);
              float ex = __builtin_amdgcn_exp2f(-z2);
              float r = __builtin_amdgcn_rcpf(1.f + ex);
              be[e] = r; om[e] = ex * r;
            }
          if (diag) {
            asm volatile("" ::: "memory");
#pragma unroll
            for (int ii = 0; ii < 4; ++ii)
#pragma unroll
              for (int j = 0; j < 4; ++j) {
                const int e = ii * 4 + j;
                const int key = k0 + (ii >> 1) * 32 + 8 * fq + (ii & 1) * 4 + j;
                const bool act = key < t;
                be[e] = act ? be[e] : 0.f; om[e] = act ? om[e] : 1.f;
              }
          }
          float cp0 = om[0], cp1 = om[8];
#pragma unroll
          for (int e = 1; e < 8; ++e) { cp0 *= om[e]; cp1 *= om[8 + e]; }
          float a0 = shfl16(cp0), a1 = shfl16(cp1);
          float pr0 = cp0 * a0, pr1 = cp1 * a1;
          float b0 = shfl32(pr0), b1 = shfl32(pr1);
          float tot0 = pr0 * b0, tot1 = pr1 * b1;
          float sfx0 = (fq == 0) ? a0 * b0 : (fq == 1) ? b0 : (fq == 2) ? a0 : 1.f;
          float sfx1 = (fq == 0) ? a1 * b1 : (fq == 1) ? b1 : (fq == 2) ? a1 : 1.f;
          float w[16];
          float P = carry[qg] * sfx1;
#pragma unroll
          for (int e = 15; e >= 8; --e) { w[e] = be[e] * P; P *= om[e]; }
          P = carry[qg] * tot1 * sfx0;
#pragma unroll
          for (int e = 7; e >= 0; --e) { w[e] = be[e] * P; P *= om[e]; }
          carry[qg] *= tot1 * tot0;
          f32x4 w0 = {w[0], w[1], w[2], w[3]}, w1 = {w[4], w[5], w[6], w[7]};
          f32x4 w2 = {w[8], w[9], w[10], w[11]}, w3 = {w[12], w[13], w[14], w[15]};
          pw[qg][0] = pack8(w0, w1); pw[qg][1] = pack8(w2, w3);
        }
      } else {
#pragma unroll
        for (int qg = 0; qg < 2; ++qg) {
          const int t = tmin + qg * 16 + fr;
          f32x4 s[4];
          st_mfma(Ks, qf[qg], s, fr, fq);
          float sv[16];
          bool lanevalid = true;
          if (KIND == 1 && i >= n_own) lanevalid = (sel[qg] >> (k0 >> 8)) & 1u;
          float mx = -3.0e38f;
#pragma unroll
          for (int ii = 0; ii < 4; ++ii)
#pragma unroll
            for (int j = 0; j < 4; ++j) {
              const int e = ii * 4 + j;
              sv[e] = s[ii][j];
            }
          if (KIND == 1 && diag) {
            asm volatile("" ::: "memory");
#pragma unroll
            for (int ii = 0; ii < 4; ++ii)
#pragma unroll
              for (int j = 0; j < 4; ++j) {
                const int key = k0 + (ii >> 1) * 32 + 8 * fq + (ii & 1) * 4 + j;
                sv[ii * 4 + j] = (key <= t) ? sv[ii * 4 + j] : -3.0e38f;
              }
          }
#pragma unroll
          for (int e = 0; e < 16; ++e) mx = fmaxf(mx, sv[e]);
          mx = lanevalid ? mx : -3.0e38f;
          mx = fmaxf(mx, shfl16(mx));
          mx = fmaxf(mx, shfl32(mx));
          const float mnew = fmaxf(mrun[qg], mx * C2);
          const float alpha = __builtin_amdgcn_exp2f(mrun[qg] - mnew);
          mrun[qg] = mnew;
          const float c2e = lanevalid ? C2 : 0.f, nb = lanevalid ? -mnew : -1e30f;
          float ps = 0.f;
#pragma unroll
          for (int e = 0; e < 16; ++e) { sv[e] = __builtin_amdgcn_exp2f(__builtin_fmaf(sv[e], c2e, nb)); ps += sv[e]; }
          lrun[qg] = lrun[qg] * alpha + ps;
          if (__any(alpha != 1.f)) {
#pragma unroll
            for (int dt = 0; dt < 4; ++dt) o[qg][dt] *= alpha;
          }
          f32x4 w0 = {sv[0], sv[1], sv[2], sv[3]}, w1 = {sv[4], sv[5], sv[6], sv[7]};
          f32x4 w2 = {sv[8], sv[9], sv[10], sv[11]}, w3 = {sv[12], sv[13], sv[14], sv[15]};
          pw[qg][0] = pack8(w0, w1); pw[qg][1] = pack8(w2, w3);
        }
      }
      pv_mfma(Vs, pw, o, fr, fq);
    }
    if (i + 1 < ntile) tile_sstore(Ksb[(i + 1) & 1], Vsb[(i + 1) & 1], tid, sk, sv2);
    if (KIND == 0) {
      const int live = (carry[0] >= 1.17549435e-38f) || (carry[1] >= 1.17549435e-38f);
      if (!__syncthreads_or(live)) return true;
    } else {
      __syncthreads();
    }
    return false;
  };
#pragma unroll 1
  for (int i = 0; i < ntile; i += 2) {
    if (step(i, rk2, rv2, rk, rv)) break;
    if (i + 1 < ntile) { if (step(i + 1, rk, rv, rk2, rv2)) break; }
  }
#pragma unroll
  for (int qg = 0; qg < 2; ++qg) {
    const int t = tmin + qg * 16 + fr;
    float scale = 1.f;
    if (KIND != 0) {
      float l = lrun[qg];
      l += shfl16(l); l += shfl32(l);
      scale = 1.f / l;
    }
#pragma unroll
    for (int dt = 0; dt < 4; ++dt) {
      uint2 gu = *(const uint2*)(gbase + (size_t)t * INC + dt * 16 + fq * 4);
      float g0 = bflo(gu.x), g1 = bfhi(gu.x), g2 = bflo(gu.y), g3 = bfhi(gu.y);
      float r0 = o[qg][dt][0] * scale * g0 * __builtin_amdgcn_rcpf(1.f + __builtin_amdgcn_exp2f(-1.4426950408889634f * g0));
      float r1 = o[qg][dt][1] * scale * g1 * __builtin_amdgcn_rcpf(1.f + __builtin_amdgcn_exp2f(-1.4426950408889634f * g1));
      float r2 = o[qg][dt][2] * scale * g2 * __builtin_amdgcn_rcpf(1.f + __builtin_amdgcn_exp2f(-1.4426950408889634f * g2));
      float r3 = o[qg][dt][3] * scale * g3 * __builtin_amdgcn_rcpf(1.f + __builtin_amdgcn_exp2f(-1.4426950408889634f * g3));
      uint2 ou; ou.x = pack2(r0, r1); ou.y = pack2(r2, r3);
      *(uint2*)(obase + (size_t)t * 1024 + dt * 16 + fq * 4) = ou;
    }
  }
}

using f32x16 = __attribute__((ext_vector_type(16))) float;
template <int KIND>
DI void attn_item32(const Params& p, int layer, int item, char* smem, int g_tid) {
  const int tid = g_tid, lane = tid & 63, wid = tid >> 6, q = lane & 31, hh = lane >> 5;
  bf16_t* Ksb[2]; bf16_t* Vsb[2];
  Ksb[0] = (bf16_t*)smem; Vsb[0] = Ksb[0] + 64 * AT_STR; Ksb[1] = Vsb[0] + 64 * AT_STR; Vsb[1] = Ksb[1] + 64 * AT_STR;
  unsigned* sU = (unsigned*)(smem + 4 * 64 * AT_STR * 2);
  int b, h, qt;
  const bf16_t *qbase, *gbase; bf16_t* obase; TileSrc ts;
  if (KIND == 0) {
    qt = 15 - (item & 15); int bh = item >> 4; h = bh % 6; b = bh / 6;
    const bf16_t* pb = p.proj + (size_t)(b * T) * INC;
    qbase = pb + C_SBQ + h * 64; gbase = pb + C_SBG + h * 64; ts.k = pb + C_SBK + h * 64; ts.kstride = INC;
    ts.v = pb + C_SBV + h * 64;
    obase = p.mixed + (size_t)(b * T) * 1024 + h * 64;
  } else if (KIND == 1) {
    qt = 15 - (item & 15); int bh = item >> 4; h = bh % 6; b = bh / 6;
    const bf16_t* pb = p.proj + (size_t)(b * T) * INC;
    qbase = pb + C_MBQ + h * 64; gbase = pb + C_MBG + h * 64; ts.k = pb + C_MBK + h * 64; ts.kstride = INC;
    ts.v = pb + C_MBV + h * 64;
    obase = p.mixed + (size_t)(b * T) * 1024 + 384 + h * 64;
  } else {
    qt = item & 15; int bh = item >> 4; h = bh & 3; b = bh >> 2;
    const bf16_t* pb = p.proj + (size_t)(b * T) * INC;
    qbase = pb + C_MQ + h * 64; gbase = pb + C_MG + h * 64;
    ts.k = p.mkv + (size_t)layer * NMEM * 512 + (size_t)(b * MEML) * 512 + h * 64; ts.kstride = 512;
    ts.v = ts.k + 256;
    obase = p.mixed + (size_t)(b * T) * 1024 + 768 + h * 64;
  }
  const int q0 = qt * 128;
  const int tmin = q0 + wid * 32, tmax = tmin + 31;
  const int t = tmin + q;
  bf16x8 qf[4];
#pragma unroll
  for (int ks = 0; ks < 4; ++ks) qf[ks] = *(const bf16x8*)(qbase + (size_t)t * INC + ks * 16 + hh * 8);
  uint2 gpre[2][4];
#pragma unroll
  for (int dt2 = 0; dt2 < 2; ++dt2)
#pragma unroll
    for (int g4 = 0; g4 < 4; ++g4) gpre[dt2][g4] = *(const uint2*)(gbase + (size_t)t * INC + dt2 * 32 + 8 * g4 + 4 * hh);
  const int own = q0 >> 8, own_start = own << 8;
  u32x4 rk[2], rv[2], rk2[2], rv2[2];
  tile_gload(ts, KIND == 0 ? ((q0 >> 6) + 1) * 64 : (KIND == 1 ? own_start : 0), tid, rk, rv);
  int ntile; unsigned U = 0; int n_own = 0; unsigned sel = 0u;
  if (KIND == 0) ntile = (q0 >> 6) + 2;
  else if (KIND == 2) ntile = 4;
  else {
    n_own = ((q0 - own_start) >> 6) + 2;
    if (own <= 3) { U = (1u << own) - 1u; sel = U; }
    else {
      f32x16 ga;
#pragma unroll
      for (int i = 0; i < 16; ++i) ga[i] = 0.f;
#pragma unroll
      for (int ks = 0; ks < 4; ++ks) {
        const float* kmp = p.kmean + (size_t)((layer * 8 + b) * 8 + (q & 7)) * 384 + h * 64 + ks * 16 + hh * 8;
        float4 k0v = *(const float4*)kmp, k1v = *(const float4*)(kmp + 4);
        float kmv[8] = {k0v.x, k0v.y, k0v.z, k0v.w, k1v.x, k1v.y, k1v.z, k1v.w};
        u32x4 hi, lo;
#pragma unroll
        for (int e = 0; e < 4; ++e) {
          float x0 = (q < 8) ? kmv[2 * e] : 0.f, x1 = (q < 8) ? kmv[2 * e + 1] : 0.f;
          bf16_t h0 = f2bf(x0), h1 = f2bf(x1);
          hi[e] = (unsigned)h0 | ((unsigned)h1 << 16);
          lo[e] = pack2(x0 - bf2f(h0), x1 - bf2f(h1));
        }
        ga = __builtin_amdgcn_mfma_f32_32x32x16_bf16(__builtin_bit_cast(bf16x8, hi), qf[ks], ga, 0, 0, 0);
        ga = __builtin_amdgcn_mfma_f32_32x32x16_bf16(__builtin_bit_cast(bf16x8, lo), qf[ks], ga, 0, 0, 0);
      }
      float gate[8];
#pragma unroll
      for (int j = 0; j < 4; ++j) {
        const float mine = ga[j], oth = shfl32(mine);
        gate[j] = hh ? oth : mine;
        gate[4 + j] = hh ? mine : oth;
      }
      unsigned sl = 0;
#pragma unroll
      for (int r = 0; r < 3; ++r) {
        float best = -3.0e38f; int bi = 0;
#pragma unroll
        for (int j = 0; j < 8; ++j) {
          bool ok = (j < own) && !((sl >> j) & 1u) && (gate[j] > best);
          best = ok ? gate[j] : best; bi = ok ? j : bi;
        }
        sl |= 1u << bi;
      }
      sel = sl;
      unsigned u = sel;
#pragma unroll
      for (int o = 32; o >= 1; o >>= 1) u |= __shfl_xor(u, o);
      __syncthreads();
      if (tid == 0) *sU = 0u;
      __syncthreads();
      if (lane == 0) atomicOr(sU, u);
      __syncthreads();
      U = *sU;
    }
    ntile = n_own + 4 * __popc(U);
  }
  auto tile_k0 = [&](int i) -> int {
    if (KIND == 0) return (ntile - 1 - i) * 64;
    if (KIND == 2) return i * 64;
    if (i < n_own) return own_start + i * 64;
    int ii = i - n_own, nb = ii >> 2, blk = 0; unsigned u = U;
    for (int c = 0; c < nb; ++c) u &= u - 1;
    blk = __ffs(u) - 1;
    return blk * 256 + (ii & 3) * 64;
  };
  f32x16 o[2];
#pragma unroll
  for (int dt2 = 0; dt2 < 2; ++dt2)
#pragma unroll
    for (int i = 0; i < 16; ++i) o[dt2][i] = 0.f;
  float mrun = -1e30f, lrun = 0.f;
  float carry = 1.f;
  const int qa = (q >> 2) & 1, qb = q >> 3, qc = q & 3;
  const int krow0 = (qb & 1) * 16 + (2 * qa + (qb >> 1)) * 4 + qc;
  const int vq4 = (lane & 15) >> 2, vp4 = lane & 3, vblk = (lane >> 4) & 1;

  __syncthreads();
  tile_sstore(Ksb[0], Vsb[0], tid, rk, rv);
  if (ntile > 1) tile_gload(ts, tile_k0(1), tid, rk, rv);
  __syncthreads();
  auto step = [&](const int i, u32x4 (&lk)[2], u32x4 (&lv)[2], const u32x4 (&sk)[2], const u32x4 (&sv2)[2]) -> bool {
    const int k0 = tile_k0(i);
    const bf16_t* Ks = Ksb[i & 1]; const bf16_t* Vs = Vsb[i & 1];
    if (i + 2 < ntile) tile_gload(ts, tile_k0(i + 2), tid, lk, lv);
    bool skip = false, diag = false;
    if (KIND == 0) { skip = (k0 >= tmax); diag = (k0 + 63 >= tmin); }
    if (KIND == 1 && i < n_own) { skip = (k0 > tmax); diag = (k0 + 63 > tmin); }
    if (!skip) {
      f32x16 s[2];
      float om[2][16];
#pragma unroll
      for (int kt2 = 0; kt2 < 2; ++kt2) {
        f32x16 z;
#pragma unroll
        for (int e = 0; e < 16; ++e) z[e] = 0.f;
#pragma unroll
        for (int ks = 0; ks < 4; ++ks) {
          const bf16x8 a = *(const bf16x8*)(Ks + (kt2 * 32 + krow0) * AT_STR + ks * 16 + hh * 8);
          z = __builtin_amdgcn_mfma_f32_32x32x16_bf16(a, qf[ks], z, 0, 0, 0);
        }
        s[kt2] = z;
      }
      if (KIND == 0) {
#pragma unroll
        for (int kt2 = 0; kt2 < 2; ++kt2)
#pragma unroll
          for (int e = 0; e < 16; ++e) {
            const float z2 = fmaxf(s[kt2][e] * C2, -100.f);
            const float ex = __builtin_amdgcn_exp2f(-z2);
            const float r = __builtin_amdgcn_rcpf(1.f + ex);
            s[kt2][e] = r; om[kt2][e] = ex * r;
          }
        if (diag) {
          asm volatile("" ::: "memory");
#pragma unroll
          for (int kt2 = 0; kt2 < 2; ++kt2)
#pragma unroll
            for (int e = 0; e < 16; ++e) {
              const bool act = (k0 + kt2 * 32 + 16 * hh + e) < t;
              s[kt2][e] = act ? s[kt2][e] : 0.f; om[kt2][e] = act ? om[kt2][e] : 1.f;
            }
        }
        float cp0 = om[0][0], cp1 = om[1][0];
#pragma unroll
        for (int e = 1; e < 16; ++e) { cp0 *= om[0][e]; cp1 *= om[1][e]; }
        const float oc0 = shfl32(cp0), oc1 = shfl32(cp1);
        const float tot0 = cp0 * oc0, tot1 = cp1 * oc1;
        float P = carry * (hh ? 1.f : oc1);
#pragma unroll
        for (int e = 15; e >= 0; --e) { const float w = s[1][e] * P; P *= om[1][e]; s[1][e] = w; }
        P = carry * tot1 * (hh ? 1.f : oc0);
#pragma unroll
        for (int e = 15; e >= 0; --e) { const float w = s[0][e] * P; P *= om[0][e]; s[0][e] = w; }
        carry *= tot0 * tot1;
      } else {
      bool lanevalid = true;
      if (KIND == 1 && i >= n_own) lanevalid = (sel >> (k0 >> 8)) & 1u;
      if (KIND == 1 && diag) {
        asm volatile("" ::: "memory");
#pragma unroll
        for (int kt2 = 0; kt2 < 2; ++kt2)
#pragma unroll
          for (int e = 0; e < 16; ++e) {
            const int key = k0 + kt2 * 32 + 16 * hh + e;
            s[kt2][e] = (key <= t) ? s[kt2][e] : -3.0e38f;
          }
      }
      float mx = -3.0e38f;
#pragma unroll
      for (int kt2 = 0; kt2 < 2; ++kt2)
#pragma unroll
        for (int e = 0; e < 16; ++e) mx = fmaxf(mx, s[kt2][e]);
      mx = lanevalid ? mx : -3.0e38f;
      mx = fmaxf(mx, shfl32(mx));
      const float mnew = fmaxf(mrun, mx * C2);
      const float alpha = __builtin_amdgcn_exp2f(mrun - mnew);
      mrun = mnew;
      const float c2e = lanevalid ? C2 : 0.f, nb = lanevalid ? -mnew : -1e30f;
      float ps = 0.f;
#pragma unroll
      for (int kt2 = 0; kt2 < 2; ++kt2)
#pragma unroll
        for (int e = 0; e < 16; ++e) { s[kt2][e] = __builtin_amdgcn_exp2f(__builtin_fmaf(s[kt2][e], c2e, nb)); ps += s[kt2][e]; }
      lrun = lrun * alpha + ps;
      if (__any(alpha != 1.f)) {
#pragma unroll
        for (int dt2 = 0; dt2 < 2; ++dt2) o[dt2] *= alpha;
      }
      }
      bf16x8 pw[2][2];
#pragma unroll
      for (int kt2 = 0; kt2 < 2; ++kt2)
#pragma unroll
        for (int s2 = 0; s2 < 2; ++s2) {
          f32x4 w0 = {s[kt2][8 * s2 + 0], s[kt2][8 * s2 + 1], s[kt2][8 * s2 + 2], s[kt2][8 * s2 + 3]};
          f32x4 w1 = {s[kt2][8 * s2 + 4], s[kt2][8 * s2 + 5], s[kt2][8 * s2 + 6], s[kt2][8 * s2 + 7]};
          pw[kt2][s2] = pack8(w0, w1);
        }
#pragma unroll
      for (int dt2 = 0; dt2 < 2; ++dt2)
#pragma unroll
        for (int kt2 = 0; kt2 < 2; ++kt2)
#pragma unroll
          for (int s2 = 0; s2 < 2; ++s2) {
            const bf16_t* vp = Vs + (kt2 * 32 + 16 * hh + 8 * s2 + vq4) * AT_STR + dt2 * 32 + vblk * 16 + 4 * vp4;
            s16x4_t lo = __builtin_amdgcn_ds_read_tr16_b64_v4i16((__attribute__((address_space(3))) s16x4_t*)(vp));
            s16x4_t hi = __builtin_amdgcn_ds_read_tr16_b64_v4i16((__attribute__((address_space(3))) s16x4_t*)(vp + 4 * AT_STR));
            bf16x8 a = __builtin_shufflevector(lo, hi, 0, 1, 2, 3, 4, 5, 6, 7);
            o[dt2] = __builtin_amdgcn_mfma_f32_32x32x16_bf16(a, pw[kt2][s2], o[dt2], 0, 0, 0);
          }
    }
    if (i + 1 < ntile) tile_sstore(Ksb[(i + 1) & 1], Vsb[(i + 1) & 1], tid, sk, sv2);
    if (KIND == 0) {
      if (!__syncthreads_or(carry >= 1.17549435e-38f)) return true;
    } else {
      __syncthreads();
    }
    return false;
  };
#pragma unroll 1
  for (int i = 0; i < ntile; i += 2) {
    if (step(i, rk2, rv2, rk, rv)) break;
    if (i + 1 < ntile) { if (step(i + 1, rk, rv, rk2, rv2)) break; }
  }
  {
    float l = lrun;
    l += shfl32(l);
    const float scale = (KIND == 0) ? 1.f : __builtin_amdgcn_rcpf(l);
#pragma unroll
    for (int dt2 = 0; dt2 < 2; ++dt2)
#pragma unroll
      for (int g4 = 0; g4 < 4; ++g4) {
        const int d0 = dt2 * 32 + 8 * g4 + 4 * hh;
        const uint2 gu = gpre[dt2][g4];
        const float gg[4] = {bflo(gu.x), bfhi(gu.x), bflo(gu.y), bfhi(gu.y)};
        float r[4];
#pragma unroll
        for (int j = 0; j < 4; ++j)
          r[j] = o[dt2][g4 * 4 + j] * scale * gg[j] * __builtin_amdgcn_rcpf(1.f + __builtin_amdgcn_exp2f(-1.4426950408889634f * gg[j]));
        uint2 ou; ou.x = pack2(r[0], r[1]); ou.y = pack2(r[2], r[3]);
        *(uint2*)(obase + (size_t)t * 1024 + d0) = ou;
      }
  }
}

DI void phase_attn(const Params& p, int layer, char* smem, int g_tid, int g_bid) {
  int* s_item = (int*)(smem + 4 * 64 * AT_STR * 2 + 16);
  unsigned* qctr = p.bar + 3456 + layer * 16;
  for (;;) {
    __syncthreads();
    if (g_tid == 0) *s_item = (int)atomicAdd(qctr, 1u);
    __syncthreads();
    const int it = *s_item;
    if (it >= 2048) break;
    if (it < 768) { int qrank = it / 48, bh = it % 48; attn_item32<1>(p, layer, bh * 16 + qrank, smem, g_tid); }
    else if (it < 1536) { int u = it - 768; int qrank = u / 48, bh = u % 48; attn_item32<0>(p, layer, bh * 16 + qrank, smem, g_tid); }
    else attn_item32<2>(p, layer, it - 1536, smem, g_tid);
  }
}

DI void phase_final(const Params& p, int g_tid, int g_bid) {
  const int lane = g_tid & 63, wid = g_tid >> 6;
  const int stride = gridDim.x * 4;
  float4 g[2][2];
#pragma unroll
  for (int i = 0; i < 2; ++i) { g[i][0] = *(const float4*)(p.final_g + i * 512 + lane * 8); g[i][1] = *(const float4*)(p.final_g + i * 512 + lane * 8 + 4); }
  for (int r0 = g_bid * 4 + wid; r0 < NTOK; r0 += 4 * stride) {
    uint4 v[4][2]; float ssv[4];
#pragma unroll
    for (int u = 0; u < 4; ++u) {
      const int r = r0 + u * stride;
      if (r < NTOK) {
        ssv[u] = p.ss[2 * NTOK + r];
#pragma unroll
        for (int i = 0; i < 2; ++i) v[u][i] = *(const uint4*)(p.xb + (size_t)r * 1024 + i * 512 + lane * 8);
      }
    }
#pragma unroll
    for (int u = 0; u < 4; ++u) {
      const int r = r0 + u * stride;
      if (r < NTOK) {
        const float rs = rsqrtf(ssv[u] * (1.f / 1024.f) + 1e-6f);
#pragma unroll
        for (int i = 0; i < 2; ++i) {
          const uint4 w = v[u][i];
          float4 o0, o1;
          o0.x = bflo(w.x) * rs * g[i][0].x; o0.y = bfhi(w.x) * rs * g[i][0].y; o0.z = bflo(w.y) * rs * g[i][0].z; o0.w = bfhi(w.y) * rs * g[i][0].w;
          o1.x = bflo(w.z) * rs * g[i][1].x; o1.y = bfhi(w.z) * rs * g[i][1].y; o1.z = bflo(w.w) * rs * g[i][1].z; o1.w = bfhi(w.w) * rs * g[i][1].w;
          *(float4*)(p.out + (size_t)r * 1024 + i * 512 + lane * 8) = o0;
          *(float4*)(p.out + (size_t)r * 1024 + i * 512 + lane * 8 + 4) = o1;
        }
      }
    }
  }
}

#define XB_TMO      128
#define XB_XCNT(j)  (256  + 64 * (j))
#define XB_XSUB(j)  (1280 + 64 * (j))
#define XB_XGEN(j)  (2304 + 64 * (j))
#define XB_TOP      3328
#define XB_TOPGEN   3392
#define XCD_BAR_WORDS 3456
#define XB_SPIN_CAP (1u << 18)
#define LAS __attribute__((address_space(3)))
DI unsigned xb_ld(unsigned* p) { return __hip_atomic_load(p, __ATOMIC_RELAXED, __HIP_MEMORY_SCOPE_AGENT); }
DI unsigned xb_add(unsigned* p, unsigned v) { return __hip_atomic_fetch_add(p, v, __ATOMIC_RELAXED, __HIP_MEMORY_SCOPE_AGENT); }
DI unsigned xb_xcc_id() { return (unsigned)__builtin_amdgcn_s_getreg((3 << 11) | 20) & 0xFu; }
#define XB_SPIN(cond, bar) do { unsigned _sp = 0; while (cond) { __builtin_amdgcn_s_sleep(1); \
    if ((++_sp & 255u) == 0u) { if (xb_ld(&(bar)[XB_TMO])) break; if (_sp > XB_SPIN_CAP) { atomicAdd(&(bar)[XB_TMO], 1u); break; } } } } while (0)
struct XcdBarrier { unsigned* bar; unsigned x; volatile LAS unsigned* st; };
DI XcdBarrier xcd_barrier_post(unsigned* bar, volatile LAS unsigned* st) {
  XcdBarrier b; b.bar = bar; b.x = xb_xcc_id(); b.st = st;
  if (threadIdx.x == 0) (void)xb_add(&bar[XB_XCNT(b.x)], 1u);
  return b;
}
DI void xcd_barrier_complete(unsigned* bar, unsigned x, unsigned& nloc, unsigned& nx) {
  const unsigned G = gridDim.x * gridDim.y * gridDim.z;
  unsigned sum, cnt, mine, sp = 0u;
  for (;;) {
    sum = 0u; cnt = 0u; mine = 0u;
#pragma unroll
    for (unsigned j = 0; j < 16; ++j) { const unsigned c = xb_ld(&bar[XB_XCNT(j)]); sum += c; cnt += (c > 0u) ? 1u : 0u; mine = (j == x) ? c : mine; }
    if (sum == G) break;
    __builtin_amdgcn_s_sleep(1);
    if ((++sp & 255u) == 0u) { if (xb_ld(&bar[XB_TMO])) break; if (sp > XB_SPIN_CAP) { atomicAdd(&bar[XB_TMO], 1u); break; } }
  }
  nloc = mine > 0u ? mine : 1u; nx = cnt > 0u ? cnt : 1u;
}
DI void xcd_barrier(const XcdBarrier& b) {
  asm volatile("s_waitcnt vmcnt(0)" ::: "memory");
  __syncthreads();
  if (threadIdx.x == 0) {
    unsigned* bar = b.bar;
    __builtin_amdgcn_s_waitcnt(0);
    unsigned nloc = b.st[0], nx = b.st[1];
    if (nloc == 0u) { xcd_barrier_complete(bar, b.x, nloc, nx); b.st[0] = nloc; b.st[1] = nx; }
    const unsigned old = xb_add(&bar[XB_XSUB(b.x)], 1u);
    const unsigned gen = old / nloc;
    if (old + 1u == (gen + 1u) * nloc) {
      __builtin_amdgcn_fence(__ATOMIC_RELEASE, "agent");
      asm volatile("s_waitcnt vmcnt(0)" ::: "memory");
      const unsigned og = xb_add(&bar[XB_TOP], 1u);
      const unsigned tg = og / nx;
      if (og + 1u == (tg + 1u) * nx) xb_add(&bar[XB_TOPGEN], 1u);
      else XB_SPIN(xb_ld(&bar[XB_TOPGEN]) == tg, bar);
      __builtin_amdgcn_fence(__ATOMIC_ACQUIRE, "agent");
      xb_add(&bar[XB_XGEN(b.x)], 1u);
      asm volatile("s_waitcnt vmcnt(0)" ::: "memory");
    } else {
      XB_SPIN(xb_ld(&bar[XB_XGEN(b.x)]) == gen, bar);
      __builtin_amdgcn_fence(__ATOMIC_ACQUIRE, "agent");
      asm volatile("s_waitcnt vmcnt(0)" ::: "memory");
    }
  }
  __syncthreads();
}

constexpr int NPHASE = 8;
#define PHASE_BEGIN(n) if (ph_lo <= (n) && (n) < ph_hi) { int g_tid = threadIdx.x, g_bid = blockIdx.x; asm volatile("" : "+v"(g_tid)); asm volatile("" : "+s"(g_bid));
#define PHASE_END(n) if ((n) + 1 < ph_hi) xcd_barrier(xb); }
__global__ void __launch_bounds__(256, 2) mega(Params p, int ph_lo, int ph_hi) {
  __shared__ __attribute__((aligned(16))) char smem[3 * G_STAGE + 64];
  __shared__ uint4 xb_words;
  cg::grid_group grid = cg::this_grid();
  if (ph_hi < 0) grid.sync();
  if (threadIdx.x == 0) xb_words = make_uint4(0u, 0u, 0u, 0u);
  __syncthreads();
  XcdBarrier xb = xcd_barrier_post(p.bar, (volatile LAS unsigned*)&xb_words);
  PHASE_BEGIN(0) phase_prepass(p, smem, g_tid, g_bid); PHASE_END(0)
  PHASE_BEGIN(1)
    {
      const int xcd = g_bid & 7, loc = g_bid >> 3, nloc = gridDim.x >> 3;
      const int nr1 = (272 + nloc - 1) / nloc; const bool stag = loc >= (nloc >> 1);
      for (int r = 0; r < nr1; ++r) {
        const int rr = stag ? (r + 3) % nr1 : r;
        const int j = loc + rr * nloc;
        if (j >= 272) continue;
        if (j < 192) gemm_tile<0, 8>(p, 0, xcd * 8 + (j & 7), j >> 3, smem, g_tid);
        else if (j < 256) { int jj = 192 + ((j - 192) >> 1), hf = j & 1; gemm_tile<0, 4>(p, 0, (xcd * 8 + (jj & 7)) * 2 + hf, jj >> 3, smem, g_tid); }
        else { int u = xcd * 16 + (j - 256); int layer = u >> 6, r = u & 63; gemm_tile<1, 4>(p, layer, r >> 2, r & 3, smem, g_tid); }
      }
    }
  PHASE_END(1)
  PHASE_BEGIN(2) phase_attn(p, 0, smem, g_tid, g_bid); PHASE_END(2)
  PHASE_BEGIN(3)
    {
      const int xcd = g_bid & 7, loc = g_bid >> 3, nloc = gridDim.x >> 3;
      for (int j = loc; j < 64; j += nloc) gemm_tile<2, 8>(p, 0, xcd * 8 + (j & 7), j >> 3, smem, g_tid);
    }
  PHASE_END(3)
  PHASE_BEGIN(4)
    {
      const int xcd = g_bid & 7, loc = g_bid >> 3, nloc = gridDim.x >> 3;
      const int nr4 = (256 + nloc - 1) / nloc; const bool stag = loc >= (nloc >> 1);
      for (int r = 0; r < nr4; ++r) {
        const int rr = stag ? (r + nr4 - 1) % nr4 : r;
        const int j = loc + rr * nloc;
        if (j >= 256) continue;
        if (j < 192) gemm_tile<0, 8>(p, 1, xcd * 8 + (j & 7), j >> 3, smem, g_tid);
        else { int jj = 192 + ((j - 192) >> 1), hf = j & 1; gemm_tile<0, 4>(p, 1, (xcd * 8 + (jj & 7)) * 2 + hf, jj >> 3, smem, g_tid); }
      }
    }
  PHASE_END(4)
  PHASE_BEGIN(5) phase_attn(p, 1, smem, g_tid, g_bid); PHASE_END(5)
  PHASE_BEGIN(6)
    {
      const int xcd = g_bid & 7, loc = g_bid >> 3, nloc = gridDim.x >> 3;
      for (int j = loc; j < 64; j += nloc) gemm_tile<2, 8>(p, 1, xcd * 8 + (j & 7), j >> 3, smem, g_tid);
    }
  PHASE_END(6)
  PHASE_BEGIN(7) phase_final(p, g_tid, g_bid); PHASE_END(7)
}

extern "C" void kernel_launch(void* const* d_in, const int* in_sizes, int n_in, void* d_out, int out_size, void* d_ws, size_t ws_size,
                              hipStream_t stream) {
  Params p{};
  p.x = (const float*)d_in[0]; p.mem = (const float*)d_in[1]; p.norm_g = (const float*)d_in[2]; p.w_in = (const float*)d_in[3];
  p.mem_norm_g = (const float*)d_in[4]; p.w_mem_kv = (const float*)d_in[5]; p.w_out = (const float*)d_in[6];
  p.final_g = (const float*)d_in[7];
  p.out = (float*)d_out;
  char* ws = (char*)d_ws;
  p.xb = (bf16_t*)(ws + 0);
  p.proj = (bf16_t*)(ws + 33554432ull);
  p.mixed = (bf16_t*)(ws + 150994944ull);
  p.wTin = (bf16_t*)(ws + 184549376ull);
  p.wTkv = (bf16_t*)(ws + 199229440ull);
  p.wTout = (bf16_t*)(ws + 201326592ull);
  p.memb = (bf16_t*)(ws + 205520896ull);
  p.mkv = (bf16_t*)(ws + 209715200ull);
  p.ss = (float*)(ws + 213909504ull);
  p.memss = (float*)(ws + 214106112ull);
  p.kmean = (float*)(ws + 214114304ull);
  p.costab = (float*)(ws + 214310912ull);
  p.sintab = (float*)(ws + 214376448ull);
  p.sbvT = (bf16_t*)(ws + 214441984ull);
  p.mbvT = (bf16_t*)(ws + 227024896ull);
  p.mvT = (bf16_t*)(ws + 239607808ull);
  p.bar = (unsigned*)(ws + 241704960ull);

  static int grid_blocks = 0;
  if (!grid_blocks) {
    int dev = 0, cus = 0, per_cu = 0;
    (void)hipGetDevice(&dev);
    (void)hipDeviceGetAttribute(&cus, hipDeviceAttributeMultiprocessorCount, dev);
    (void)hipOccupancyMaxActiveBlocksPerMultiprocessor(&per_cu, mega, 256, 0);
    if (per_cu > 2) per_cu = 2;
    if (per_cu < 1) per_cu = 1;
    grid_blocks = cus * per_cu;
  }
#if MULTI_LAUNCH
  for (int ph = 0; ph < NPHASE; ++ph) {
    if (NAIVE_ATTN && (ph == 2 || ph == 5)) {
      int layer = ph == 2 ? 0 : 1;
      hipLaunchKernelGGL(attn_naive_sb, dim3(384), dim3(256), 0, stream, p, layer);
      hipLaunchKernelGGL(attn_naive_moba, dim3(384), dim3(256), 0, stream, p, layer);
      hipLaunchKernelGGL(attn_naive_mem, dim3(256), dim3(256), 0, stream, p, layer);
    } else {
      hipLaunchKernelGGL(mega, dim3(grid_blocks), dim3(256), 0, stream, p, ph, ph + 1);
    }
  }
#else
  int lo = 0, hi = NPHASE;
  (void)hipMemsetAsync(p.bar, 0, (XCD_BAR_WORDS + 64) * sizeof(unsigned), stream);
  void* args[] = {&p, &lo, &hi};
  hipError_t e = hipLaunchCooperativeKernel((void*)mega, dim3(grid_blocks), dim3(256), args, 0, stream);
  if (e != hipSuccess) fprintf(stderr, "cooperative launch failed: %s (grid %d)\n", hipGetErrorString(e), grid_blocks);
#endif
}
```

```cpp
#include <hip/hip_runtime.h>
#include <hip/hip_cooperative_groups.h>
#include <stdint.h>
#include <cstdio>
namespace cg = cooperative_groups;

#ifndef MULTI_LAUNCH
#define MULTI_LAUNCH 0
#endif
#ifndef NAIVE_ATTN
#define NAIVE_ATTN 0
#endif

typedef unsigned short bf16_t;
using bf16x8 = __attribute__((ext_vector_type(8))) short;
using f32x4 = __attribute__((ext_vector_type(4))) float;
using u32x4 = __attribute__((ext_vector_type(4))) unsigned;
#define DI __device__ __forceinline__

constexpr int NB = 8, T = 2048, D = 1024, NTOK = NB * T, INC = 3584, MEML = 256, NMEM = NB * MEML;
constexpr int C_SBQ = 0, C_SBK = 384, C_SBV = 768, C_SBG = 1152, C_MBQ = 1536, C_MBK = 1920, C_MBV = 2304, C_MBG = 2688,
              C_MQ = 3072, C_MG = 3328;

struct Params {
  const float* x; const float* mem; const float* norm_g; const float* w_in; const float* mem_norm_g;
  const float* w_mem_kv; const float* w_out; const float* final_g;
  float* out;
  bf16_t* xb; bf16_t* proj; bf16_t* mixed; bf16_t* wTin; bf16_t* wTkv; bf16_t* wTout; bf16_t* memb; bf16_t* mkv;
  float* ss; float* memss; float* kmean; float* costab; float* sintab;
  bf16_t* sbvT; bf16_t* mbvT; bf16_t* mvT;
  unsigned* bar;
};

DI bf16_t f2bf(float x) { unsigned u = __float_as_uint(x); u += 0x7fffu + ((u >> 16) & 1u); return (bf16_t)(u >> 16); }
DI float bf2f(bf16_t b) { return __uint_as_float(((unsigned)b) << 16); }
DI float bflo(unsigned u) { return __uint_as_float(u << 16); }
DI float bfhi(unsigned u) { return __uint_as_float(u & 0xffff0000u); }
typedef float f32x2_t __attribute__((ext_vector_type(2)));
typedef __bf16 bf16x2_t __attribute__((ext_vector_type(2)));
DI unsigned pack2(float a, float b) { f32x2_t v = {a, b}; return __builtin_bit_cast(unsigned, __builtin_convertvector(v, bf16x2_t)); }
DI float4 ld_nt4(const float* ptr) { f32x4 t = __builtin_nontemporal_load((const f32x4*)ptr); return float4{t[0], t[1], t[2], t[3]}; }
DI float shfl16(float x) {
  const unsigned u = __float_as_uint(x);
  auto r = __builtin_amdgcn_permlane16_swap(u, u, false, false);
  return __uint_as_float((r[0] == u) ? r[1] : r[0]);
}
DI float shfl32(float x) {
  const unsigned u = __float_as_uint(x);
  auto r = __builtin_amdgcn_permlane32_swap(u, u, false, false);
  return __uint_as_float((r[0] == u) ? r[1] : r[0]);
}
DI float wave_sum(float v) {
#pragma unroll
  for (int o = 32; o >= 1; o >>= 1) v += __shfl_xor(v, o);
  return v;
}

DI void transpose_tile(const float* __restrict__ src, const float* __restrict__ g, bf16_t* __restrict__ dst, int N, int kt, int nt,
                       float* tile, int g_tid) {
  const int tid = g_tid;
  __syncthreads();
#pragma unroll
  for (int pss = 0; pss < 4; ++pss) {
    int kr = pss * 16 + (tid >> 4), nc = (tid & 15) * 4;
    int k = kt * 64 + kr;
    float4 v = ld_nt4(src + (size_t)k * N + nt * 64 + nc);
    float gs = g ? g[k] : 1.f;
    tile[kr * 65 + nc + 0] = v.x * gs; tile[kr * 65 + nc + 1] = v.y * gs;
    tile[kr * 65 + nc + 2] = v.z * gs; tile[kr * 65 + nc + 3] = v.w * gs;
  }
  __syncthreads();
#pragma unroll
  for (int pss = 0; pss < 2; ++pss) {
    int nr = pss * 32 + (tid >> 3), kc = (tid & 7) * 8;
    uint4 o;
    o.x = pack2(tile[(kc + 0) * 65 + nr], tile[(kc + 1) * 65 + nr]);
    o.y = pack2(tile[(kc + 2) * 65 + nr], tile[(kc + 3) * 65 + nr]);
    o.z = pack2(tile[(kc + 4) * 65 + nr], tile[(kc + 5) * 65 + nr]);
    o.w = pack2(tile[(kc + 6) * 65 + nr], tile[(kc + 7) * 65 + nr]);
    *(uint4*)(dst + (size_t)(nt * 64 + nr) * 1024 + kt * 64 + kc) = o;
  }
}

DI void row_convert(const float* __restrict__ src, bf16_t* __restrict__ dst, float* __restrict__ ssout, int row, int lane) {
  const float* r = src + (size_t)row * 1024;
  float s = 0.f;
#pragma unroll
  for (int i = 0; i < 2; ++i) {
    int c = i * 512 + lane * 8;
    float4 a = *(const float4*)(r + c), b = *(const float4*)(r + c + 4);
    s += a.x * a.x + a.y * a.y + a.z * a.z + a.w * a.w + b.x * b.x + b.y * b.y + b.z * b.z + b.w * b.w;
    uint4 o; o.x = pack2(a.x, a.y); o.y = pack2(a.z, a.w); o.z = pack2(b.x, b.y); o.w = pack2(b.z, b.w);
    *(uint4*)(dst + (size_t)row * 1024 + c) = o;
  }
  s = wave_sum(s);
  if (lane == 0) ssout[row] = s;
}

DI void phase_prepass(const Params& p, char* smem, int g_tid, int g_bid) {
  const int tid = g_tid, lane = tid & 63, wid = tid >> 6;
  const int gtid = g_bid * 256 + tid, gth = gridDim.x * 256;
  for (int i = gtid; i < 2 * 8 * 8 * 384; i += gth) p.kmean[i] = 0.f;
  for (int i = gtid; i < 2 * NTOK; i += gth) p.ss[NTOK + i] = 0.f;
  for (int i = gtid; i < T * 8; i += gth) {
    int pos = i >> 3, f = i & 7;
    const float invf[8] = {1.000000000e+00f, 1.939227447e-01f, 3.760603093e-02f, 7.292664737e-03f, 1.414213562e-03f, 2.742481757e-04f, 5.318295897e-05f, 1.031338538e-05f};
    float inv = invf[0];
#pragma unroll
    for (int q = 1; q < 8; ++q) inv = (f == q) ? invf[q] : inv;
    float ang = (float)pos * inv;
    p.costab[i] = cosf(ang); p.sintab[i] = sinf(ang);
  }
  const int NT_IN = 16 * 56, NT_KV = 16 * 8, NT_OUT = 16 * 16;
  const int per_layer = NT_IN + NT_KV + NT_OUT;
  for (int job = g_bid; job < 2 * per_layer; job += gridDim.x) {
    int layer = job / per_layer, j = job % per_layer;
    if (j < NT_IN) {
      transpose_tile(p.w_in + (size_t)layer * 1024 * INC, p.norm_g + layer * 1024, p.wTin + (size_t)layer * INC * 1024, INC, j / 56, j % 56,
                     (float*)smem, g_tid);
    } else if (j < NT_IN + NT_KV) {
      j -= NT_IN;
      transpose_tile(p.w_mem_kv + (size_t)layer * 1024 * 512, p.mem_norm_g + layer * 1024, p.wTkv + (size_t)layer * 512 * 1024, 512, j / 8,
                     j % 8, (float*)smem, g_tid);
    } else {
      j -= NT_IN + NT_KV;
      transpose_tile(p.w_out + (size_t)layer * 1024 * 1024, nullptr, p.wTout + (size_t)layer * 1024 * 1024, 1024, j / 16, j % 16,
                     (float*)smem, g_tid);
    }
  }
  {
    const int stride = gridDim.x * 4;
    for (int r0 = g_bid * 4 + wid; r0 < NTOK + NMEM; r0 += 3 * stride) {
      float4 va[3][4];
#pragma unroll
      for (int u = 0; u < 3; ++u) {
        const int r = r0 + u * stride;
        if (r < NTOK + NMEM) {
          const float* rp = (r < NTOK) ? p.x + (size_t)r * 1024 : p.mem + (size_t)(r - NTOK) * 1024;
#pragma unroll
          for (int i = 0; i < 2; ++i) { va[u][2 * i] = ld_nt4(rp + i * 512 + lane * 8); va[u][2 * i + 1] = ld_nt4(rp + i * 512 + lane * 8 + 4); }
        }
      }
#pragma unroll
      for (int u = 0; u < 3; ++u) {
        const int r = r0 + u * stride;
        if (r < NTOK + NMEM) {
          bf16_t* dp = (r < NTOK) ? p.xb + (size_t)r * 1024 : p.memb + (size_t)(r - NTOK) * 1024;
          float sacc = 0.f;
#pragma unroll
          for (int i = 0; i < 2; ++i) {
            const float4 a = va[u][2 * i], b = va[u][2 * i + 1];
            sacc += a.x * a.x + a.y * a.y + a.z * a.z + a.w * a.w + b.x * b.x + b.y * b.y + b.z * b.z + b.w * b.w;
            uint4 o; o.x = pack2(a.x, a.y); o.y = pack2(a.z, a.w); o.z = pack2(b.x, b.y); o.w = pack2(b.z, b.w);
            *(uint4*)(dp + i * 512 + lane * 8) = o;
          }
          sacc = wave_sum(sacc);
          if (lane == 0) { if (r < NTOK) p.ss[r] = sacc; else p.memss[r - NTOK] = sacc; }
        }
      }
    }
  }
}

constexpr int LDS_STR = 72;
constexpr int G_STAGE = (256 + 128) * 64;

template <int MODE, int MT>
DI void gemm_tile(const Params& p, int layer, int mt, int nt, char* smem, int g_tid) {
  const int tid = g_tid, lane = tid & 63, wid = tid >> 6, wr = wid >> 1, wc = wid & 1;
  const int fr = lane & 15, fq = lane >> 4;
  const bf16_t* A; const bf16_t* Bt;
  if (MODE == 0) { A = p.xb; Bt = p.wTin + (size_t)layer * INC * 1024; }
  else if (MODE == 1) { A = p.memb; Bt = p.wTkv + (size_t)layer * 512 * 1024; }
  else { A = p.mixed; Bt = p.wTout + (size_t)layer * 1024 * 1024; }
  const bf16_t* Ag = A + (size_t)(mt * (MT * 32)) * 1024;
  const bf16_t* Bg = Bt + (size_t)(nt * 128) * 1024;
  f32x4 acc[MT][4];
#pragma unroll
  for (int m = 0; m < MT; ++m)
#pragma unroll
    for (int n = 0; n < 4; ++n) acc[m][n] = f32x4{0.f, 0.f, 0.f, 0.f};
  constexpr int NLD = (MT == 8) ? 6 : 4;
  u32x4 rgA[NLD], rgB[NLD];
  const unsigned goff0 = (unsigned)((tid >> 2) * 2048 + (((tid & 3) ^ (((tid >> 5) & 1) * 3)) * 16));
  const int sbase = tid * 16;
  const char* Ab = (const char*)Ag; const char* Bb = (const char*)Bg;
#define G_LOAD(R, KT) _Pragma("unroll") for (int i = 0; i < NLD; ++i) { \
    const int ii = (MT == 8) ? i : (i < 2 ? i : i + 2); \
    const char* gb = ((ii < 4) ? Ab + ii * 131072 : Bb + (ii - 4) * 131072) + (KT) * 64; \
    R[i] = *(const u32x4*)(gb + goff0); }
#define G_STORE(R, ST) _Pragma("unroll") for (int i = 0; i < NLD; ++i) { \
    const int ii = (MT == 8) ? i : (i < 2 ? i : i + 2); \
    *(u32x4*)((ST) + ii * 4096 + sbase) = R[i]; }
#define G_COMPUTE(ST) { const char* st = (ST); bf16x8 b[4]; \
    _Pragma("unroll") for (int n = 0; n < 4; ++n) b[n] = *(const bf16x8*)(st + boff + (n >> 1) * 2048 + (n & 1) * 256); \
    _Pragma("unroll") for (int mh = 0; mh < MT; mh += 4) { bf16x8 a[4]; \
      _Pragma("unroll") for (int m = 0; m < 4; ++m) a[m] = *(const bf16x8*)(st + aoff + (mh + m) * 1024); \
      __builtin_amdgcn_s_setprio(1); \
      _Pragma("unroll") for (int m = 0; m < 4; ++m) \
        _Pragma("unroll") for (int n = 0; n < 4; ++n) acc[mh + m][n] = __builtin_amdgcn_mfma_f32_16x16x32_bf16(b[n], a[m], acc[mh + m][n], 0, 0, 0); \
      __builtin_amdgcn_s_setprio(0); } }
  const int aoff = (wr * (MT * 16) + fr) * 64 + ((fq ^ (((fr >> 3) & 1) * 3)) & 3) * 16;
  const int boff = 16384 + (wc * 64 + 8 * (fr >> 2) + (fr & 3)) * 64 + ((fq ^ (((fr >> 2) & 1) * 3)) & 3) * 16;
  G_LOAD(rgA, 0)
  G_STORE(rgA, smem)
  G_LOAD(rgA, 1)
  G_LOAD(rgB, 2)
#pragma unroll 1
  for (int kt = 0; kt < 32; kt += 2) {
    __syncthreads();
    G_STORE(rgA, smem + G_STAGE)
    if (kt + 3 < 32) G_LOAD(rgA, kt + 3)
    G_COMPUTE(smem)
    __syncthreads();
    if (kt + 2 < 32) G_STORE(rgB, smem)
    if (kt + 4 < 32) G_LOAD(rgB, kt + 4)
    G_COMPUTE(smem + G_STAGE)
  }
#undef G_LOAD
#undef G_STORE
#undef G_COMPUTE
  const int cb = nt * 128 + wc * 64;
  const int rb0 = mt * (MT * 32) + wr * (MT * 16);
  if (MODE == 0) {
    const bool rot = (cb >= C_MBQ && cb < C_MBV);
    const bool km = (cb >= C_MBK && cb < C_MBV);
    f32x4 colsum[4];
#pragma unroll
    for (int n = 0; n < 4; ++n) colsum[n] = f32x4{0.f, 0.f, 0.f, 0.f};
    float rsv[MT];
#pragma unroll
    for (int m = 0; m < MT; ++m) rsv[m] = p.ss[layer * NTOK + rb0 + m * 16 + fr];
#pragma unroll
    for (int m = 0; m < MT; ++m) rsv[m] = rsqrtf(rsv[m] * (1.f / 1024.f) + 1e-6f);
#pragma unroll
    for (int m = 0; m < MT; ++m) {
      const int grow = rb0 + m * 16 + fr;
      const float rs = rsv[m];
#pragma unroll
      for (int pp = 0; pp < 2; ++pp) {
        f32x4 v0 = acc[m][2 * pp] * rs, v1 = acc[m][2 * pp + 1] * rs;
        if (pp == 0 && rot) {
          const int pos = grow & (T - 1);
          const float4 c0 = *(const float4*)(p.costab + pos * 8), c1 = *(const float4*)(p.costab + pos * 8 + 4);
          const float4 s0 = *(const float4*)(p.sintab + pos * 8), s1 = *(const float4*)(p.sintab + pos * 8 + 4);
          const float cc[8] = {c0.x, c0.y, c0.z, c0.w, c1.x, c1.y, c1.z, c1.w};
          const float sn[8] = {s0.x, s0.y, s0.z, s0.w, s1.x, s1.y, s1.z, s1.w};
#pragma unroll
          for (int j = 0; j < 4; ++j) {
            const float p0 = shfl16(v0[j]), p1 = shfl16(v1[j]);
            const float r0 = (fq == 0) ? (v0[j] * cc[j] - p0 * sn[j]) : (v0[j] * cc[j] + p0 * sn[j]);
            const float r1 = (fq == 0) ? (v1[j] * cc[4 + j] - p1 * sn[4 + j]) : (v1[j] * cc[4 + j] + p1 * sn[4 + j]);
            v0[j] = (fq < 2) ? r0 : v0[j];
            v1[j] = (fq < 2) ? r1 : v1[j];
          }
        }
        if (km) { colsum[2 * pp] += v0; colsum[2 * pp + 1] += v1; }
        uint4 o; o.x = pack2(v0[0], v0[1]); o.y = pack2(v0[2], v0[3]); o.z = pack2(v1[0], v1[1]); o.w = pack2(v1[2], v1[3]);
        *(uint4*)(p.proj + (size_t)grow * INC + cb + pp * 32 + fq * 8) = o;
      }
      if (m & 1) asm volatile("" ::: "memory");
    }
    if (km) {
      const int b = rb0 / T, blk = (rb0 % T) / 256;
#pragma unroll
      for (int n = 0; n < 4; ++n)
#pragma unroll
        for (int j = 0; j < 4; ++j) {
          float sm = colsum[n][j];
          sm += __shfl_xor(sm, 1); sm += __shfl_xor(sm, 2); sm += __shfl_xor(sm, 4); sm += __shfl_xor(sm, 8);
          if (fr == 0) atomicAdd(&p.kmean[((layer * 8 + b) * 8 + blk) * 384 + (cb - C_MBK) + (n >> 1) * 32 + fq * 8 + (n & 1) * 4 + j], sm);
        }
    }
  } else if (MODE == 1) {
    float rsv[MT];
#pragma unroll
    for (int m = 0; m < MT; ++m) rsv[m] = p.memss[rb0 + m * 16 + fr];
#pragma unroll
    for (int m = 0; m < MT; ++m) rsv[m] = rsqrtf(rsv[m] * (1.f / 1024.f) + 1e-6f);
#pragma unroll
    for (int m = 0; m < MT; ++m) {
      const int grow = rb0 + m * 16 + fr;
#pragma unroll
      for (int pp = 0; pp < 2; ++pp) {
        f32x4 v0 = acc[m][2 * pp] * rsv[m], v1 = acc[m][2 * pp + 1] * rsv[m];
        uint4 o; o.x = pack2(v0[0], v0[1]); o.y = pack2(v0[2], v0[3]); o.z = pack2(v1[0], v1[1]); o.w = pack2(v1[2], v1[3]);
        *(uint4*)(p.mkv + (size_t)layer * NMEM * 512 + (size_t)grow * 512 + cb + pp * 32 + fq * 8) = o;
      }
      if (m & 1) asm volatile("" ::: "memory");
    }
  } else {
    if (layer == 0) {
#pragma unroll
      for (int mp = 0; mp < MT / 2; ++mp) {
        uint4 xo[2][2];
#pragma unroll
        for (int h2 = 0; h2 < 2; ++h2)
#pragma unroll
          for (int pp = 0; pp < 2; ++pp)
            xo[h2][pp] = *(const uint4*)(p.xb + (size_t)(rb0 + (mp * 2 + h2) * 16 + fr) * 1024 + cb + pp * 32 + fq * 8);
#pragma unroll
        for (int h2 = 0; h2 < 2; ++h2) {
          const int m = mp * 2 + h2;
          const int grow = rb0 + m * 16 + fr;
          float sq = 0.f;
#pragma unroll
          for (int pp = 0; pp < 2; ++pp) {
            const size_t idx = (size_t)grow * 1024 + cb + pp * 32 + fq * 8;
            const uint4 u = xo[h2][pp];
            float4 xa, xc;
            xa.x = bflo(u.x) + acc[m][2 * pp][0]; xa.y = bfhi(u.x) + acc[m][2 * pp][1];
            xa.z = bflo(u.y) + acc[m][2 * pp][2]; xa.w = bfhi(u.y) + acc[m][2 * pp][3];
            xc.x = bflo(u.z) + acc[m][2 * pp + 1][0]; xc.y = bfhi(u.z) + acc[m][2 * pp + 1][1];
            xc.z = bflo(u.w) + acc[m][2 * pp + 1][2]; xc.w = bfhi(u.w) + acc[m][2 * pp + 1][3];
            uint4 o; o.x = pack2(xa.x, xa.y); o.y = pack2(xa.z, xa.w); o.z = pack2(xc.x, xc.y); o.w = pack2(xc.z, xc.w);
            *(uint4*)(p.xb + idx) = o;
            sq += xa.x * xa.x + xa.y * xa.y + xa.z * xa.z + xa.w * xa.w + xc.x * xc.x + xc.y * xc.y + xc.z * xc.z + xc.w * xc.w;
          }
          sq += shfl16(sq); sq += shfl32(sq);
          if (fq == 0) atomicAdd(&p.ss[NTOK + grow], sq);
        }
        asm volatile("" ::: "memory");
      }
    } else {
#pragma unroll
      for (int mp = 0; mp < MT / 2; ++mp) {
        uint4 xo[2][2];
#pragma unroll
        for (int h2 = 0; h2 < 2; ++h2)
#pragma unroll
          for (int pp = 0; pp < 2; ++pp)
            xo[h2][pp] = *(const uint4*)(p.xb + (size_t)(rb0 + (mp * 2 + h2) * 16 + fr) * 1024 + cb + pp * 32 + fq * 8);
#pragma unroll
        for (int h2 = 0; h2 < 2; ++h2) {
          const int m = mp * 2 + h2;
          const int grow = rb0 + m * 16 + fr;
          float sq = 0.f;
#pragma unroll
          for (int pp = 0; pp < 2; ++pp) {
            const size_t idx = (size_t)grow * 1024 + cb + pp * 32 + fq * 8;
            const uint4 u = xo[h2][pp];
            float4 xa, xc;
            xa.x = bflo(u.x) + acc[m][2 * pp][0]; xa.y = bfhi(u.x) + acc[m][2 * pp][1];
            xa.z = bflo(u.y) + acc[m][2 * pp][2]; xa.w = bfhi(u.y) + acc[m][2 * pp][3];
            xc.x = bflo(u.z) + acc[m][2 * pp + 1][0]; xc.y = bfhi(u.z) + acc[m][2 * pp + 1][1];
            xc.z = bflo(u.w) + acc[m][2 * pp + 1][2]; xc.w = bfhi(u.w) + acc[m][2 * pp + 1][3];
            { uint4 o; o.x = pack2(xa.x, xa.y); o.y = pack2(xa.z, xa.w); o.z = pack2(xc.x, xc.y); o.w = pack2(xc.z, xc.w);
              *(uint4*)(p.xb + idx) = o; }
            sq += xa.x * xa.x + xa.y * xa.y + xa.z * xa.z + xa.w * xa.w + xc.x * xc.x + xc.y * xc.y + xc.z * xc.z + xc.w * xc.w;
          }
          sq += shfl16(sq); sq += shfl32(sq);
          if (fq == 0) atomicAdd(&p.ss[2 * NTOK + grow], sq);
        }
        asm volatile("" ::: "memory");
      }
    }
  }
}

DI void load_row64(const bf16_t* __restrict__ ptr, float (&r)[64], float scale) {
#pragma unroll
  for (int i = 0; i < 8; ++i) {
    uint4 u = *(const uint4*)(ptr + i * 8);
    r[i * 8 + 0] = bflo(u.x) * scale; r[i * 8 + 1] = bfhi(u.x) * scale;
    r[i * 8 + 2] = bflo(u.y) * scale; r[i * 8 + 3] = bfhi(u.y) * scale;
    r[i * 8 + 4] = bflo(u.z) * scale; r[i * 8 + 5] = bfhi(u.z) * scale;
    r[i * 8 + 6] = bflo(u.w) * scale; r[i * 8 + 7] = bfhi(u.w) * scale;
  }
}
DI float dot_row64(const bf16_t* __restrict__ ptr, const float (&q)[64]) {
  float z = 0.f;
#pragma unroll
  for (int i = 0; i < 8; ++i) {
    uint4 u = *(const uint4*)(ptr + i * 8);
    z += q[i * 8 + 0] * bflo(u.x); z += q[i * 8 + 1] * bfhi(u.x);
    z += q[i * 8 + 2] * bflo(u.y); z += q[i * 8 + 3] * bfhi(u.y);
    z += q[i * 8 + 4] * bflo(u.z); z += q[i * 8 + 5] * bfhi(u.z);
    z += q[i * 8 + 6] * bflo(u.w); z += q[i * 8 + 7] * bfhi(u.w);
  }
  return z;
}
DI void axpy_row64(const bf16_t* __restrict__ ptr, float w, float (&acc)[64]) {
#pragma unroll
  for (int i = 0; i < 8; ++i) {
    uint4 u = *(const uint4*)(ptr + i * 8);
    acc[i * 8 + 0] += w * bflo(u.x); acc[i * 8 + 1] += w * bfhi(u.x);
    acc[i * 8 + 2] += w * bflo(u.y); acc[i * 8 + 3] += w * bfhi(u.y);
    acc[i * 8 + 4] += w * bflo(u.z); acc[i * 8 + 5] += w * bfhi(u.z);
    acc[i * 8 + 6] += w * bflo(u.w); acc[i * 8 + 7] += w * bfhi(u.w);
  }
}
DI void gate_store(const bf16_t* __restrict__ gp, bf16_t* __restrict__ op, const float (&acc)[64], float scale) {
#pragma unroll
  for (int i = 0; i < 8; ++i) {
    uint4 u = *(const uint4*)(gp + i * 8);
    float g[8] = {bflo(u.x), bfhi(u.x), bflo(u.y), bfhi(u.y), bflo(u.z), bfhi(u.z), bflo(u.w), bfhi(u.w)};
    float o[8];
#pragma unroll
    for (int e = 0; e < 8; ++e) o[e] = acc[i * 8 + e] * scale * (g[e] / (1.f + __expf(-g[e])));
    uint4 w; w.x = pack2(o[0], o[1]); w.y = pack2(o[2], o[3]); w.z = pack2(o[4], o[5]); w.w = pack2(o[6], o[7]);
    *(uint4*)(op + i * 8) = w;
  }
}

DI void sb_naive_wave(const Params& p, int layer, int item, int lane) {
  const int qc = 31 - (item & 31), bh = item >> 5, h = bh % 6, b = bh / 6;
  const int t = qc * 64 + lane;
  const bf16_t* base = p.proj + (size_t)(b * T) * INC;
  float q[64], acc[64];
  load_row64(base + (size_t)t * INC + C_SBQ + h * 64, q, 0.125f);
#pragma unroll
  for (int d = 0; d < 64; ++d) acc[d] = 0.f;
  float carry = 0.f;
  for (int s = qc * 64 + 62; s >= 0; --s) {
    const bf16_t* kp = base + (size_t)s * INC + C_SBK + h * 64;
    float z = dot_row64(kp, q);
    bool act = s < t;
    float lb = fminf(z, 0.f) - log1pf(expf(-fabsf(z)));
    float w = act ? expf(lb + carry) : 0.f;
    carry += act ? (lb - z) : 0.f;
    axpy_row64(kp + (C_SBV - C_SBK), w, acc);
  }
  gate_store(base + (size_t)t * INC + C_SBG + h * 64, p.mixed + (size_t)(b * T + t) * 1024 + h * 64, acc, 1.f);
}

DI void os_step(const float (&q)[64], float& m, float& l, float (&acc)[64], const bf16_t* kp, const bf16_t* vp, bool valid) {
  float sc = dot_row64(kp, q);
  sc = valid ? sc : -1e30f;
  float mn = fmaxf(m, sc);
  float alpha = __expf(m - mn);
  float pw = valid ? __expf(sc - mn) : 0.f;
  l = l * alpha + pw;
  m = mn;
#pragma unroll
  for (int d = 0; d < 64; ++d) acc[d] *= alpha;
  axpy_row64(vp, pw, acc);
}

DI void moba_naive_wave(const Params& p, int layer, int item, int lane) {
  const int qc = 31 - (item & 31), bh = item >> 5, h = bh % 6, b = bh / 6;
  const int t = qc * 64 + lane, own = qc >> 2;
  const bf16_t* base = p.proj + (size_t)(b * T) * INC;
  float q[64], acc[64];
  load_row64(base + (size_t)t * INC + C_MBQ + h * 64, q, 1.f);
  unsigned sel = 0;
  if (own <= 3) sel = (1u << own) - 1u;
  else {
    float gate[8];
#pragma unroll
    for (int j = 0; j < 8; ++j) {
      float gsum = 0.f;
      if (j < own) {
        const float* km = p.kmean + ((layer * 8 + b) * 8 + j) * 384 + h * 64;
#pragma unroll
        for (int d = 0; d < 64; ++d) gsum += q[d] * km[d];
      }
      gate[j] = gsum;
    }
#pragma unroll
    for (int r = 0; r < 3; ++r) {
      float best = -3.0e38f; int bi = 0;
#pragma unroll
      for (int j = 0; j < 8; ++j) {
        bool ok = (j < own) && !((sel >> j) & 1u) && (gate[j] > best);
        best = ok ? gate[j] : best; bi = ok ? j : bi;
      }
      sel |= 1u << bi;
    }
  }
#pragma unroll
  for (int d = 0; d < 64; ++d) { acc[d] = 0.f; q[d] *= 0.125f; }
  float m = -1e30f, l = 0.f;
  for (int j = 0; j < own; ++j) {
    bool v = (sel >> j) & 1u;
    if (__ballot(v) == 0ull) continue;
    for (int s = j * 256; s < j * 256 + 256; ++s) {
      const bf16_t* kp = base + (size_t)s * INC + C_MBK + h * 64;
      os_step(q, m, l, acc, kp, kp + (C_MBV - C_MBK), v);
    }
  }
  for (int s = own * 256; s <= qc * 64 + 63; ++s) {
    const bf16_t* kp = base + (size_t)s * INC + C_MBK + h * 64;
    os_step(q, m, l, acc, kp, kp + (C_MBV - C_MBK), s <= t);
  }
  gate_store(base + (size_t)t * INC + C_MBG + h * 64, p.mixed + (size_t)(b * T + t) * 1024 + 384 + h * 64, acc, 1.f / l);
}

DI void mem_naive_wave(const Params& p, int layer, int item, int lane) {
  const int qc = item & 31, bh = item >> 5, h = bh & 3, b = bh >> 2;
  const int t = qc * 64 + lane;
  const bf16_t* base = p.proj + (size_t)(b * T) * INC;
  float q[64], acc[64];
  load_row64(base + (size_t)t * INC + C_MQ + h * 64, q, 0.125f);
#pragma unroll
  for (int d = 0; d < 64; ++d) acc[d] = 0.f;
  float m = -1e30f, l = 0.f;
  const bf16_t* kv = p.mkv + (size_t)layer * NMEM * 512 + (size_t)(b * MEML) * 512 + h * 64;
  for (int s = 0; s < MEML; ++s) os_step(q, m, l, acc, kv + (size_t)s * 512, kv + (size_t)s * 512 + 256, true);
  gate_store(base + (size_t)t * INC + C_MG + h * 64, p.mixed + (size_t)(b * T + t) * 1024 + 768 + h * 64, acc, 1.f / l);
}

__global__ void __launch_bounds__(256) attn_naive_sb(Params p, int layer) {
  sb_naive_wave(p, layer, blockIdx.x * 4 + (threadIdx.x >> 6), threadIdx.x & 63);
}
__global__ void __launch_bounds__(256) attn_naive_moba(Params p, int layer) {
  moba_naive_wave(p, layer, blockIdx.x * 4 + (threadIdx.x >> 6), threadIdx.x & 63);
}
__global__ void __launch_bounds__(256) attn_naive_mem(Params p, int layer) {
  mem_naive_wave(p, layer, blockIdx.x * 4 + (threadIdx.x >> 6), threadIdx.x & 63);
}

constexpr int AT_STR = 72;
constexpr float C2 = 0.125f * 1.4426950408889634f;

DI bf16x8 pack8(const f32x4& a, const f32x4& b) {
  u32x4 r;
  r[0] = pack2(a[0], a[1]); r[1] = pack2(a[2], a[3]); r[2] = pack2(b[0], b[1]); r[3] = pack2(b[2], b[3]);
  return __builtin_bit_cast(bf16x8, r);
}

struct TileSrc { const bf16_t* k; int kstride; const bf16_t* v; };

DI void tile_gload(const TileSrc& ts, int k0, int tid, u32x4 (&rk)[2], u32x4 (&rv)[2]) {
  const unsigned toff = (unsigned)((tid >> 3) * ts.kstride * 2 + (tid & 7) * 16);
#pragma unroll
  for (int i = 0; i < 2; ++i) {
    const char* kb = (const char*)ts.k + (size_t)(k0 + 32 * i) * ts.kstride * 2;
    const char* vb = (const char*)ts.v + (size_t)(k0 + 32 * i) * ts.kstride * 2;
    rk[i] = *(const u32x4*)(kb + toff);
    rv[i] = *(const u32x4*)(vb + toff);
  }
}
DI void tile_sstore(bf16_t* Ks, bf16_t* Vs, int tid, const u32x4 (&rk)[2], const u32x4 (&rv)[2]) {
#pragma unroll
  for (int i = 0; i < 2; ++i) {
    int c = tid + i * 256, row = c >> 3, ch = c & 7;
    int kk = row & 31;
    int rho = (row & 32) + ((kk >> 2) & 1) * 16 + (kk >> 3) * 4 + (kk & 3);
    *(u32x4*)(Ks + rho * AT_STR + ch * 8) = rk[i];
    *(u32x4*)(Vs + row * AT_STR + ch * 8) = rv[i];
  }
}

DI void st_mfma(const bf16_t* Ks, const bf16x8 (&qf)[2], f32x4 (&s)[4], int fr, int fq) {
#pragma unroll
  for (int i = 0; i < 4; ++i) {
    bf16x8 a0 = *(const bf16x8*)(Ks + (i * 16 + fr) * AT_STR + fq * 8);
    bf16x8 a1 = *(const bf16x8*)(Ks + (i * 16 + fr) * AT_STR + 32 + fq * 8);
    f32x4 z = {0.f, 0.f, 0.f, 0.f};
    z = __builtin_amdgcn_mfma_f32_16x16x32_bf16(a0, qf[0], z, 0, 0, 0);
    z = __builtin_amdgcn_mfma_f32_16x16x32_bf16(a1, qf[1], z, 0, 0, 0);
    s[i] = z;
  }
}
typedef short s16x4_t __attribute__((ext_vector_type(4)));
DI void pv_mfma(const bf16_t* Vs, const bf16x8 (&pw)[2][2], f32x4 (&o)[2][4], int fr, int fq) {
  const int q = fr >> 2, pp = fr & 3;
#pragma unroll
  for (int dt = 0; dt < 4; ++dt) {
#pragma unroll
    for (int st = 0; st < 2; ++st) {
      const bf16_t* a0p = Vs + (st * 32 + fq * 8 + q) * AT_STR + dt * 16 + 4 * pp;
      s16x4_t lo = __builtin_amdgcn_ds_read_tr16_b64_v4i16((__attribute__((address_space(3))) s16x4_t*)(a0p));
      s16x4_t hi = __builtin_amdgcn_ds_read_tr16_b64_v4i16((__attribute__((address_space(3))) s16x4_t*)(a0p + 4 * AT_STR));
      bf16x8 a = __builtin_shufflevector(lo, hi, 0, 1, 2, 3, 4, 5, 6, 7);
#pragma unroll
      for (int qg = 0; qg < 2; ++qg) o[qg][dt] = __builtin_amdgcn_mfma_f32_16x16x32_bf16(a, pw[qg][st], o[qg][dt], 0, 0, 0);
    }
  }
}

template <int KIND>
DI void attn_item(const Params& p, int layer, int item, char* smem, int g_tid) {
  const int tid = g_tid, lane = tid & 63, wid = tid >> 6, fr = lane & 15, fq = lane >> 4;
  bf16_t* Ksb[2]; bf16_t* Vsb[2];
  Ksb[0] = (bf16_t*)smem; Vsb[0] = Ksb[0] + 64 * AT_STR; Ksb[1] = Vsb[0] + 64 * AT_STR; Vsb[1] = Ksb[1] + 64 * AT_STR;
  unsigned* sU = (unsigned*)(smem + 4 * 64 * AT_STR * 2);
  int b, h, qt;
  const bf16_t *qbase, *gbase; bf16_t* obase; TileSrc ts;
  if (KIND == 0) {
    qt = 15 - (item & 15); int bh = item >> 4; h = bh % 6; b = bh / 6;
    const bf16_t* pb = p.proj + (size_t)(b * T) * INC;
    qbase = pb + C_SBQ + h * 64; gbase = pb + C_SBG + h * 64; ts.k = pb + C_SBK + h * 64; ts.kstride = INC;
    ts.v = pb + C_SBV + h * 64;
    obase = p.mixed + (size_t)(b * T) * 1024 + h * 64;
  } else if (KIND == 1) {
    qt = 15 - (item & 15); int bh = item >> 4; h = bh % 6; b = bh / 6;
    const bf16_t* pb = p.proj + (size_t)(b * T) * INC;
    qbase = pb + C_MBQ + h * 64; gbase = pb + C_MBG + h * 64; ts.k = pb + C_MBK + h * 64; ts.kstride = INC;
    ts.v = pb + C_MBV + h * 64;
    obase = p.mixed + (size_t)(b * T) * 1024 + 384 + h * 64;
  } else {
    qt = item & 15; int bh = item >> 4; h = bh & 3; b = bh >> 2;
    const bf16_t* pb = p.proj + (size_t)(b * T) * INC;
    qbase = pb + C_MQ + h * 64; gbase = pb + C_MG + h * 64;
    ts.k = p.mkv + (size_t)layer * NMEM * 512 + (size_t)(b * MEML) * 512 + h * 64; ts.kstride = 512;
    ts.v = ts.k + 256;
    obase = p.mixed + (size_t)(b * T) * 1024 + 768 + h * 64;
  }
  const int q0 = qt * 128;
  const int tmin = q0 + wid * 32, tmax = tmin + 31;
  bf16x8 qf[2][2];
#pragma unroll
  for (int qg = 0; qg < 2; ++qg)
#pragma unroll
    for (int ks = 0; ks < 2; ++ks)
      qf[qg][ks] = *(const bf16x8*)(qbase + (size_t)(tmin + qg * 16 + fr) * INC + ks * 32 + fq * 8);

  const int own = q0 >> 8, own_start = own << 8;
  u32x4 rk[2], rv[2], rk2[2], rv2[2];
  tile_gload(ts, KIND == 0 ? ((q0 >> 6) + 1) * 64 : (KIND == 1 ? own_start : 0), tid, rk, rv);
  int ntile; unsigned U = 0; int n_own = 0;
  unsigned sel[2] = {0u, 0u};
  if (KIND == 0) ntile = (q0 >> 6) + 2;
  else if (KIND == 2) ntile = 4;
  else {
    n_own = ((q0 - own_start) >> 6) + 2;
    if (own <= 3) { U = (1u << own) - 1u; sel[0] = sel[1] = U; }
    else {
      f32x4 ga[2];
      ga[0] = f32x4{0.f, 0.f, 0.f, 0.f}; ga[1] = ga[0];
#pragma unroll
      for (int ks = 0; ks < 2; ++ks) {
        float kmv[8];
        const float* kmp = p.kmean + (size_t)((layer * 8 + b) * 8 + (fr & 7)) * 384 + h * 64 + ks * 32 + fq * 8;
        float4 k0v = *(const float4*)kmp, k1v = *(const float4*)(kmp + 4);
        kmv[0] = k0v.x; kmv[1] = k0v.y; kmv[2] = k0v.z; kmv[3] = k0v.w; kmv[4] = k1v.x; kmv[5] = k1v.y; kmv[6] = k1v.z; kmv[7] = k1v.w;
        u32x4 hi, lo;
#pragma unroll
        for (int e = 0; e < 4; ++e) {
          float x0 = (fr < 8) ? kmv[2 * e] : 0.f, x1 = (fr < 8) ? kmv[2 * e + 1] : 0.f;
          bf16_t h0 = f2bf(x0), h1 = f2bf(x1);
          hi[e] = (unsigned)h0 | ((unsigned)h1 << 16);
          lo[e] = pack2(x0 - bf2f(h0), x1 - bf2f(h1));
        }
        bf16x8 ah = __builtin_bit_cast(bf16x8, hi), al = __builtin_bit_cast(bf16x8, lo);
#pragma unroll
        for (int qg = 0; qg < 2; ++qg) {
          ga[qg] = __builtin_amdgcn_mfma_f32_16x16x32_bf16(ah, qf[qg][ks], ga[qg], 0, 0, 0);
          ga[qg] = __builtin_amdgcn_mfma_f32_16x16x32_bf16(al, qf[qg][ks], ga[qg], 0, 0, 0);
        }
      }
#pragma unroll
      for (int qg = 0; qg < 2; ++qg) {
        float gate[8];
#pragma unroll
        for (int j = 0; j < 4; ++j) {
          float mine = ga[qg][j], oth = shfl16(mine);
          gate[j] = (fq & 1) ? oth : mine;
          gate[4 + j] = (fq & 1) ? mine : oth;
        }
        unsigned sl = 0;
#pragma unroll
        for (int r = 0; r < 3; ++r) {
          float best = -3.0e38f; int bi = 0;
#pragma unroll
          for (int j = 0; j < 8; ++j) {
            bool ok = (j < own) && !((sl >> j) & 1u) && (gate[j] > best);
            best = ok ? gate[j] : best; bi = ok ? j : bi;
          }
          sl |= 1u << bi;
        }
        sl = __shfl(sl, lane & 31);
        sel[qg] = sl;
      }
      unsigned u = sel[0] | sel[1];
#pragma unroll
      for (int o = 32; o >= 1; o >>= 1) u |= __shfl_xor(u, o);
      __syncthreads();
      if (tid == 0) *sU = 0u;
      __syncthreads();
      if (lane == 0) atomicOr(sU, u);
      __syncthreads();
      U = *sU;
    }
    ntile = n_own + 4 * __popc(U);
  }
  auto tile_k0 = [&](int i) -> int {
    if (KIND == 0) return (ntile - 1 - i) * 64;
    if (KIND == 2) return i * 64;
    if (i < n_own) return own_start + i * 64;
    int ii = i - n_own, nb = ii >> 2, blk = 0; unsigned u = U;
    for (int c = 0; c < nb; ++c) u &= u - 1;
    blk = __ffs(u) - 1;
    return blk * 256 + (ii & 3) * 64;
  };

  f32x4 o[2][4];
#pragma unroll
  for (int qg = 0; qg < 2; ++qg)
#pragma unroll
    for (int dt = 0; dt < 4; ++dt) o[qg][dt] = f32x4{0.f, 0.f, 0.f, 0.f};
  float carry[2] = {1.f, 1.f};
  float mrun[2] = {-1e30f, -1e30f}, lrun[2] = {0.f, 0.f};

  __syncthreads();
  tile_sstore(Ksb[0], Vsb[0], tid, rk, rv);
  if (ntile > 1) tile_gload(ts, tile_k0(1), tid, rk, rv);
  __syncthreads();
  auto step = [&](const int i, u32x4 (&lk)[2], u32x4 (&lv)[2], const u32x4 (&sk)[2], const u32x4 (&sv2)[2]) -> bool {
    const int k0 = tile_k0(i);
    const bf16_t* Ks = Ksb[i & 1]; const bf16_t* Vs = Vsb[i & 1];
    if (i + 2 < ntile) tile_gload(ts, tile_k0(i + 2), tid, lk, lv);
    bool skip = false, diag = false;
    if (KIND == 0) { skip = (k0 >= tmax); diag = (k0 + 63 >= tmin); }
    if (KIND == 1 && i < n_own) { skip = (k0 > tmax); diag = (k0 + 63 > tmin); }
    if (!skip) {
      bf16x8 pw[2][2];
      if (KIND == 0) {
#pragma unroll
        for (int qg = 0; qg < 2; ++qg) {
          const int t = tmin + qg * 16 + fr;
          f32x4 s[4];
          st_mfma(Ks, qf[qg], s, fr, fq);
          float om[16], be[16];
#pragma unroll
          for (int ii = 0; ii < 4; ++ii)
#pragma unroll
            for (int j = 0; j < 4; ++j) {
              const int e = ii * 4 + j;
              float z2 = fmaxf(s[ii][j] * C2, -100.f);
              float ex = __builtin_amdgcn_exp2f(-z2);
              float r = __builtin_amdgcn_rcpf(1.f + ex);
              be[e] = r; om[e] = ex * r;
            }
          if (diag) {
            asm volatile("" ::: "memory");
#pragma unroll
            for (int ii = 0; ii < 4; ++ii)
#pragma unroll
              for (int j = 0; j < 4; ++j) {
                const int e = ii * 4 + j;
                const int key = k0 + (ii >> 1) * 32 + 8 * fq + (ii & 1) * 4 + j;
                const bool act = key < t;
                be[e] = act ? be[e] : 0.f; om[e] = act ? om[e] : 1.f;
              }
          }
          float cp0 = om[0], cp1 = om[8];
#pragma unroll
          for (int e = 1; e < 8; ++e) { cp0 *= om[e]; cp1 *= om[8 + e]; }
          float a0 = shfl16(cp0), a1 = shfl16(cp1);
          float pr0 = cp0 * a0, pr1 = cp1 * a1;
          float b0 = shfl32(pr0), b1 = shfl32(pr1);
          float tot0 = pr0 * b0, tot1 = pr1 * b1;
          float sfx0 = (fq == 0) ? a0 * b0 : (fq == 1) ? b0 : (fq == 2) ? a0 : 1.f;
          float sfx1 = (fq == 0) ? a1 * b1 : (fq == 1) ? b1 : (fq == 2) ? a1 : 1.f;
          float w[16];
          float P = carry[qg] * sfx1;
#pragma unroll
          for (int e = 15; e >= 8; --e) { w[e] = be[e] * P; P *= om[e]; }
          P = carry[qg] * tot1 * sfx0;
#pragma unroll
          for (int e = 7; e >= 0; --e) { w[e] = be[e] * P; P *= om[e]; }
          carry[qg] *= tot1 * tot0;
          f32x4 w0 = {w[0], w[1], w[2], w[3]}, w1 = {w[4], w[5], w[6], w[7]};
          f32x4 w2 = {w[8], w[9], w[10], w[11]}, w3 = {w[12], w[13], w[14], w[15]};
          pw[qg][0] = pack8(w0, w1); pw[qg][1] = pack8(w2, w3);
        }
      } else {
#pragma unroll
        for (int qg = 0; qg < 2; ++qg) {
          const int t = tmin + qg * 16 + fr;
          f32x4 s[4];
          st_mfma(Ks, qf[qg], s, fr, fq);
          float sv[16];
          bool lanevalid = true;
          if (KIND == 1 && i >= n_own) lanevalid = (sel[qg] >> (k0 >> 8)) & 1u;
          float mx = -3.0e38f;
#pragma unroll
          for (int ii = 0; ii < 4; ++ii)
#pragma unroll
            for (int j = 0; j < 4; ++j) {
              const int e = ii * 4 + j;
              sv[e] = s[ii][j];
            }
          if (KIND == 1 && diag) {
            asm volatile("" ::: "memory");
#pragma unroll
            for (int ii = 0; ii < 4; ++ii)
#pragma unroll
              for (int j = 0; j < 4; ++j) {
                const int key = k0 + (ii >> 1) * 32 + 8 * fq + (ii & 1) * 4 + j;
                sv[ii * 4 + j] = (key <= t) ? sv[ii * 4 + j] : -3.0e38f;
              }
          }
#pragma unroll
          for (int e = 0; e < 16; ++e) mx = fmaxf(mx, sv[e]);
          mx = lanevalid ? mx : -3.0e38f;
          mx = fmaxf(mx, shfl16(mx));
          mx = fmaxf(mx, shfl32(mx));
          const float mnew = fmaxf(mrun[qg], mx * C2);
          const float alpha = __builtin_amdgcn_exp2f(mrun[qg] - mnew);
          mrun[qg] = mnew;
          const float c2e = lanevalid ? C2 : 0.f, nb = lanevalid ? -mnew : -1e30f;
          float ps = 0.f;
#pragma unroll
          for (int e = 0; e < 16; ++e) { sv[e] = __builtin_amdgcn_exp2f(__builtin_fmaf(sv[e], c2e, nb)); ps += sv[e]; }
          lrun[qg] = lrun[qg] * alpha + ps;
          if (__any(alpha != 1.f)) {
#pragma unroll
            for (int dt = 0; dt < 4; ++dt) o[qg][dt] *= alpha;
          }
          f32x4 w0 = {sv[0], sv[1], sv[2], sv[3]}, w1 = {sv[4], sv[5], sv[6], sv[7]};
          f32x4 w2 = {sv[8], sv[9], sv[10], sv[11]}, w3 = {sv[12], sv[13], sv[14], sv[15]};
          pw[qg][0] = pack8(w0, w1); pw[qg][1] = pack8(w2, w3);
        }
      }
      pv_mfma(Vs, pw, o, fr, fq);
    }
    if (i + 1 < ntile) tile_sstore(Ksb[(i + 1) & 1], Vsb[(i + 1) & 1], tid, sk, sv2);
    if (KIND == 0) {
      const int live = (carry[0] >= 1.17549435e-38f) || (carry[1] >= 1.17549435e-38f);
      if (!__syncthreads_or(live)) return true;
    } else {
      __syncthreads();
    }
    return false;
  };
#pragma unroll 1
  for (int i = 0; i < ntile; i += 2) {
    if (step(i, rk2, rv2, rk, rv)) break;
    if (i + 1 < ntile) { if (step(i + 1, rk, rv, rk2, rv2)) break; }
  }
#pragma unroll
  for (int qg = 0; qg < 2; ++qg) {
    const int t = tmin + qg * 16 + fr;
    float scale = 1.f;
    if (KIND != 0) {
      float l = lrun[qg];
      l += shfl16(l); l += shfl32(l);
      scale = 1.f / l;
    }
#pragma unroll
    for (int dt = 0; dt < 4; ++dt) {
      uint2 gu = *(const uint2*)(gbase + (size_t)t * INC + dt * 16 + fq * 4);
      float g0 = bflo(gu.x), g1 = bfhi(gu.x), g2 = bflo(gu.y), g3 = bfhi(gu.y);
      float r0 = o[qg][dt][0] * scale * g0 * __builtin_amdgcn_rcpf(1.f + __builtin_amdgcn_exp2f(-1.4426950408889634f * g0));
      float r1 = o[qg][dt][1] * scale * g1 * __builtin_amdgcn_rcpf(1.f + __builtin_amdgcn_exp2f(-1.4426950408889634f * g1));
      float r2 = o[qg][dt][2] * scale * g2 * __builtin_amdgcn_rcpf(1.f + __builtin_amdgcn_exp2f(-1.4426950408889634f * g2));
      float r3 = o[qg][dt][3] * scale * g3 * __builtin_amdgcn_rcpf(1.f + __builtin_amdgcn_exp2f(-1.4426950408889634f * g3));
      uint2 ou; ou.x = pack2(r0, r1); ou.y = pack2(r2, r3);
      *(uint2*)(obase + (size_t)t * 1024 + dt * 16 + fq * 4) = ou;
    }
  }
}

using f32x16 = __attribute__((ext_vector_type(16))) float;
template <int KIND>
DI void attn_item32(const Params& p, int layer, int item, char* smem, int g_tid) {
  const int tid = g_tid, lane = tid & 63, wid = tid >> 6, q = lane & 31, hh = lane >> 5;
  bf16_t* Ksb[2]; bf16_t* Vsb[2];
  Ksb[0] = (bf16_t*)smem; Vsb[0] = Ksb[0] + 64 * AT_STR; Ksb[1] = Vsb[0] + 64 * AT_STR; Vsb[1] = Ksb[1] + 64 * AT_STR;
  unsigned* sU = (unsigned*)(smem + 4 * 64 * AT_STR * 2);
  int b, h, qt;
  const bf16_t *qbase, *gbase; bf16_t* obase; TileSrc ts;
  if (KIND == 0) {
    qt = 15 - (item & 15); int bh = item >> 4; h = bh % 6; b = bh / 6;
    const bf16_t* pb = p.proj + (size_t)(b * T) * INC;
    qbase = pb + C_SBQ + h * 64; gbase = pb + C_SBG + h * 64; ts.k = pb + C_SBK + h * 64; ts.kstride = INC;
    ts.v = pb + C_SBV + h * 64;
    obase = p.mixed + (size_t)(b * T) * 1024 + h * 64;
  } else if (KIND == 1) {
    qt = 15 - (item & 15); int bh = item >> 4; h = bh % 6; b = bh / 6;
    const bf16_t* pb = p.proj + (size_t)(b * T) * INC;
    qbase = pb + C_MBQ + h * 64; gbase = pb + C_MBG + h * 64; ts.k = pb + C_MBK + h * 64; ts.kstride = INC;
    ts.v = pb + C_MBV + h * 64;
    obase = p.mixed + (size_t)(b * T) * 1024 + 384 + h * 64;
  } else {
    qt = item & 15; int bh = item >> 4; h = bh & 3; b = bh >> 2;
    const bf16_t* pb = p.proj + (size_t)(b * T) * INC;
    qbase = pb + C_MQ + h * 64; gbase = pb + C_MG + h * 64;
    ts.k = p.mkv + (size_t)layer * NMEM * 512 + (size_t)(b * MEML) * 512 + h * 64; ts.kstride = 512;
    ts.v = ts.k + 256;
    obase = p.mixed + (size_t)(b * T) * 1024 + 768 + h * 64;
  }
  const int q0 = qt * 128;
  const int tmin = q0 + wid * 32, tmax = tmin + 31;
  const int t = tmin + q;
  bf16x8 qf[4];
#pragma unroll
  for (int ks = 0; ks < 4; ++ks) qf[ks] = *(const bf16x8*)(qbase + (size_t)t * INC + ks * 16 + hh * 8);
  uint2 gpre[2][4];
#pragma unroll
  for (int dt2 = 0; dt2 < 2; ++dt2)
#pragma unroll
    for (int g4 = 0; g4 < 4; ++g4) gpre[dt2][g4] = *(const uint2*)(gbase + (size_t)t * INC + dt2 * 32 + 8 * g4 + 4 * hh);
  const int own = q0 >> 8, own_start = own << 8;
  u32x4 rk[2], rv[2], rk2[2], rv2[2];
  tile_gload(ts, KIND == 0 ? ((q0 >> 6) + 1) * 64 : (KIND == 1 ? own_start : 0), tid, rk, rv);
  int ntile; unsigned U = 0; int n_own = 0; unsigned sel = 0u;
  if (KIND == 0) ntile = (q0 >> 6) + 2;
  else if (KIND == 2) ntile = 4;
  else {
    n_own = ((q0 - own_start) >> 6) + 2;
    if (own <= 3) { U = (1u << own) - 1u; sel = U; }
    else {
      f32x16 ga;
#pragma unroll
      for (int i = 0; i < 16; ++i) ga[i] = 0.f;
#pragma unroll
      for (int ks = 0; ks < 4; ++ks) {
        const float* kmp = p.kmean + (size_t)((layer * 8 + b) * 8 + (q & 7)) * 384 + h * 64 + ks * 16 + hh * 8;
        float4 k0v = *(const float4*)kmp, k1v = *(const float4*)(kmp + 4);
        float kmv[8] = {k0v.x, k0v.y, k0v.z, k0v.w, k1v.x, k1v.y, k1v.z, k1v.w};
        u32x4 hi, lo;
#pragma unroll
        for (int e = 0; e < 4; ++e) {
          float x0 = (q < 8) ? kmv[2 * e] : 0.f, x1 = (q < 8) ? kmv[2 * e + 1] : 0.f;
          bf16_t h0 = f2bf(x0), h1 = f2bf(x1);
          hi[e] = (unsigned)h0 | ((unsigned)h1 << 16);
          lo[e] = pack2(x0 - bf2f(h0), x1 - bf2f(h1));
        }
        ga = __builtin_amdgcn_mfma_f32_32x32x16_bf16(__builtin_bit_cast(bf16x8, hi), qf[ks], ga, 0, 0, 0);
        ga = __builtin_amdgcn_mfma_f32_32x32x16_bf16(__builtin_bit_cast(bf16x8, lo), qf[ks], ga, 0, 0, 0);
      }
      float gate[8];
#pragma unroll
      for (int j = 0; j < 4; ++j) {
        const float mine = ga[j], oth = shfl32(mine);
        gate[j] = hh ? oth : mine;
        gate[4 + j] = hh ? mine : oth;
      }
      unsigned sl = 0;
#pragma unroll
      for (int r = 0; r < 3; ++r) {
        float best = -3.0e38f; int bi = 0;
#pragma unroll
        for (int j = 0; j < 8; ++j) {
          bool ok = (j < own) && !((sl >> j) & 1u) && (gate[j] > best);
          best = ok ? gate[j] : best; bi = ok ? j : bi;
        }
        sl |= 1u << bi;
      }
      sel = sl;
      unsigned u = sel;
#pragma unroll
      for (int o = 32; o >= 1; o >>= 1) u |= __shfl_xor(u, o);
      __syncthreads();
      if (tid == 0) *sU = 0u;
      __syncthreads();
      if (lane == 0) atomicOr(sU, u);
      __syncthreads();
      U = *sU;
    }
    ntile = n_own + 4 * __popc(U);
  }
  auto tile_k0 = [&](int i) -> int {
    if (KIND == 0) return (ntile - 1 - i) * 64;
    if (KIND == 2) return i * 64;
    if (i < n_own) return own_start + i * 64;
    int ii = i - n_own, nb = ii >> 2, blk = 0; unsigned u = U;
    for (int c = 0; c < nb; ++c) u &= u - 1;
    blk = __ffs(u) - 1;
    return blk * 256 + (ii & 3) * 64;
  };
  f32x16 o[2];
#pragma unroll
  for (int dt2 = 0; dt2 < 2; ++dt2)
#pragma unroll
    for (int i = 0; i < 16; ++i) o[dt2][i] = 0.f;
  float mrun = -1e30f, lrun = 0.f;
  float carry = 1.f;
  const int qa = (q >> 2) & 1, qb = q >> 3, qc = q & 3;
  const int krow0 = (qb & 1) * 16 + (2 * qa + (qb >> 1)) * 4 + qc;
  const int vq4 = (lane & 15) >> 2, vp4 = lane & 3, vblk = (lane >> 4) & 1;

  __syncthreads();
  tile_sstore(Ksb[0], Vsb[0], tid, rk, rv);
  if (ntile > 1) tile_gload(ts, tile_k0(1), tid, rk, rv);
  __syncthreads();
  auto step = [&](const int i, u32x4 (&lk)[2], u32x4 (&lv)[2], const u32x4 (&sk)[2], const u32x4 (&sv2)[2]) -> bool {
    const int k0 = tile_k0(i);
    const bf16_t* Ks = Ksb[i & 1]; const bf16_t* Vs = Vsb[i & 1];
    if (i + 2 < ntile) tile_gload(ts, tile_k0(i + 2), tid, lk, lv);
    bool skip = false, diag = false;
    if (KIND == 0) { skip = (k0 >= tmax); diag = (k0 + 63 >= tmin); }
    if (KIND == 1 && i < n_own) { skip = (k0 > tmax); diag = (k0 + 63 > tmin); }
    if (!skip) {
      f32x16 s[2];
      float om[2][16];
#pragma unroll
      for (int kt2 = 0; kt2 < 2; ++kt2) {
        f32x16 z;
#pragma unroll
        for (int e = 0; e < 16; ++e) z[e] = 0.f;
#pragma unroll
        for (int ks = 0; ks < 4; ++ks) {
          const bf16x8 a = *(const bf16x8*)(Ks + (kt2 * 32 + krow0) * AT_STR + ks * 16 + hh * 8);
          z = __builtin_amdgcn_mfma_f32_32x32x16_bf16(a, qf[ks], z, 0, 0, 0);
        }
        s[kt2] = z;
      }
      if (KIND == 0) {
#pragma unroll
        for (int kt2 = 0; kt2 < 2; ++kt2)
#pragma unroll
          for (int e = 0; e < 16; ++e) {
            const float z2 = fmaxf(s[kt2][e] * C2, -100.f);
            const float ex = __builtin_amdgcn_exp2f(-z2);
            const float r = __builtin_amdgcn_rcpf(1.f + ex);
            s[kt2][e] = r; om[kt2][e] = ex * r;
          }
        if (diag) {
          asm volatile("" ::: "memory");
#pragma unroll
          for (int kt2 = 0; kt2 < 2; ++kt2)
#pragma unroll
            for (int e = 0; e < 16; ++e) {
              const bool act = (k0 + kt2 * 32 + 16 * hh + e) < t;
              s[kt2][e] = act ? s[kt2][e] : 0.f; om[kt2][e] = act ? om[kt2][e] : 1.f;
            }
        }
        float cp0 = om[0][0], cp1 = om[1][0];
#pragma unroll
        for (int e = 1; e < 16; ++e) { cp0 *= om[0][e]; cp1 *= om[1][e]; }
        const float oc0 = shfl32(cp0), oc1 = shfl32(cp1);
        const float tot0 = cp0 * oc0, tot1 = cp1 * oc1;
        float P = carry * (hh ? 1.f : oc1);
#pragma unroll
        for (int e = 15; e >= 0; --e) { const float w = s[1][e] * P; P *= om[1][e]; s[1][e] = w; }
        P = carry * tot1 * (hh ? 1.f : oc0);
#pragma unroll
        for (int e = 15; e >= 0; --e) { const float w = s[0][e] * P; P *= om[0][e]; s[0][e] = w; }
        carry *= tot0 * tot1;
      } else {
      bool lanevalid = true;
      if (KIND == 1 && i >= n_own) lanevalid = (sel >> (k0 >> 8)) & 1u;
      if (KIND == 1 && diag) {
        asm volatile("" ::: "memory");
#pragma unroll
        for (int kt2 = 0; kt2 < 2; ++kt2)
#pragma unroll
          for (int e = 0; e < 16; ++e) {
            const int key = k0 + kt2 * 32 + 16 * hh + e;
            s[kt2][e] = (key <= t) ? s[kt2][e] : -3.0e38f;
          }
      }
      float mx = -3.0e38f;
#pragma unroll
      for (int kt2 = 0; kt2 < 2; ++kt2)
#pragma unroll
        for (int e = 0; e < 16; ++e) mx = fmaxf(mx, s[kt2][e]);
      mx = lanevalid ? mx : -3.0e38f;
      mx = fmaxf(mx, shfl32(mx));
      const float mnew = fmaxf(mrun, mx * C2);
      const float alpha = __builtin_amdgcn_exp2f(mrun - mnew);
      mrun = mnew;
      const float c2e = lanevalid ? C2 : 0.f, nb = lanevalid ? -mnew : -1e30f;
      float ps = 0.f;
#pragma unroll
      for (int kt2 = 0; kt2 < 2; ++kt2)
#pragma unroll
        for (int e = 0; e < 16; ++e) { s[kt2][e] = __builtin_amdgcn_exp2f(__builtin_fmaf(s[kt2][e], c2e, nb)); ps += s[kt2][e]; }
      lrun = lrun * alpha + ps;
      if (__any(alpha != 1.f)) {
#pragma unroll
        for (int dt2 = 0; dt2 < 2; ++dt2) o[dt2] *= alpha;
      }
      }
      bf16x8 pw[2][2];
#pragma unroll
      for (int kt2 = 0; kt2 < 2; ++kt2)
#pragma unroll
        for (int s2 = 0; s2 < 2; ++s2) {
          f32x4 w0 = {s[kt2][8 * s2 + 0], s[kt2][8 * s2 + 1], s[kt2][8 * s2 + 2], s[kt2][8 * s2 + 3]};
          f32x4 w1 = {s[kt2][8 * s2 + 4], s[kt2][8 * s2 + 5], s[kt2][8 * s2 + 6], s[kt2][8 * s2 + 7]};
          pw[kt2][s2] = pack8(w0, w1);
        }
#pragma unroll
      for (int dt2 = 0; dt2 < 2; ++dt2)
#pragma unroll
        for (int kt2 = 0; kt2 < 2; ++kt2)
#pragma unroll
          for (int s2 = 0; s2 < 2; ++s2) {
            const bf16_t* vp = Vs + (kt2 * 32 + 16 * hh + 8 * s2 + vq4) * AT_STR + dt2 * 32 + vblk * 16 + 4 * vp4;
            s16x4_t lo = __builtin_amdgcn_ds_read_tr16_b64_v4i16((__attribute__((address_space(3))) s16x4_t*)(vp));
            s16x4_t hi = __builtin_amdgcn_ds_read_tr16_b64_v4i16((__attribute__((address_space(3))) s16x4_t*)(vp + 4 * AT_STR));
            bf16x8 a = __builtin_shufflevector(lo, hi, 0, 1, 2, 3, 4, 5, 6, 7);
            o[dt2] = __builtin_amdgcn_mfma_f32_32x32x16_bf16(a, pw[kt2][s2], o[dt2], 0, 0, 0);
          }
    }
    if (i + 1 < ntile) tile_sstore(Ksb[(i + 1) & 1], Vsb[(i + 1) & 1], tid, sk, sv2);
    if (KIND == 0) {
      if (!__syncthreads_or(carry >= 1.17549435e-38f)) return true;
    } else {
      __syncthreads();
    }
    return false;
  };
#pragma unroll 1
  for (int i = 0; i < ntile; i += 2) {
    if (step(i, rk2, rv2, rk, rv)) break;
    if (i + 1 < ntile) { if (step(i + 1, rk, rv, rk2, rv2)) break; }
  }
  {
    float l = lrun;
    l += shfl32(l);
    const float scale = (KIND == 0) ? 1.f : __builtin_amdgcn_rcpf(l);
#pragma unroll
    for (int dt2 = 0; dt2 < 2; ++dt2)
#pragma unroll
      for (int g4 = 0; g4 < 4; ++g4) {
        const int d0 = dt2 * 32 + 8 * g4 + 4 * hh;
        const uint2 gu = gpre[dt2][g4];
        const float gg[4] = {bflo(gu.x), bfhi(gu.x), bflo(gu.y), bfhi(gu.y)};
        float r[4];
#pragma unroll
        for (int j = 0; j < 4; ++j)
          r[j] = o[dt2][g4 * 4 + j] * scale * gg[j] * __builtin_amdgcn_rcpf(1.f + __builtin_amdgcn_exp2f(-1.4426950408889634f * gg[j]));
        uint2 ou; ou.x = pack2(r[0], r[1]); ou.y = pack2(r[2], r[3]);
        *(uint2*)(obase + (size_t)t * 1024 + d0) = ou;
      }
  }
}

DI void phase_attn(const Params& p, int layer, char* smem, int g_tid, int g_bid) {
  int* s_item = (int*)(smem + 4 * 64 * AT_STR * 2 + 16);
  unsigned* qctr = p.bar + 3456 + layer * 16;
  bool first = true;
  for (;;) {
    __syncthreads();
    if (g_tid == 0) *s_item = first ? g_bid : (int)(gridDim.x + atomicAdd(qctr, 1u));
    first = false;
    __syncthreads();
    const int it = *s_item;
    if (it >= 2048) break;
    if (it < 768) { int qrank = it / 48, bh = it % 48; attn_item32<1>(p, layer, bh * 16 + qrank, smem, g_tid); }
    else if (it < 1536) { int u = it - 768; int qrank = u / 48, bh = u % 48; attn_item32<0>(p, layer, bh * 16 + qrank, smem, g_tid); }
    else attn_item32<2>(p, layer, it - 1536, smem, g_tid);
  }
}

DI void phase_final(const Params& p, int g_tid, int g_bid) {
  const int lane = g_tid & 63, wid = g_tid >> 6;
  const int stride = gridDim.x * 4;
  float4 g[2][2];
#pragma unroll
  for (int i = 0; i < 2; ++i) { g[i][0] = *(const float4*)(p.final_g + i * 512 + lane * 8); g[i][1] = *(const float4*)(p.final_g + i * 512 + lane * 8 + 4); }
  for (int r0 = g_bid * 4 + wid; r0 < NTOK; r0 += 4 * stride) {
    uint4 v[4][2]; float ssv[4];
#pragma unroll
    for (int u = 0; u < 4; ++u) {
      const int r = r0 + u * stride;
      if (r < NTOK) {
        ssv[u] = p.ss[2 * NTOK + r];
#pragma unroll
        for (int i = 0; i < 2; ++i) v[u][i] = *(const uint4*)(p.xb + (size_t)r * 1024 + i * 512 + lane * 8);
      }
    }
#pragma unroll
    for (int u = 0; u < 4; ++u) {
      const int r = r0 + u * stride;
      if (r < NTOK) {
        const float rs = rsqrtf(ssv[u] * (1.f / 1024.f) + 1e-6f);
#pragma unroll
        for (int i = 0; i < 2; ++i) {
          const uint4 w = v[u][i];
          float4 o0, o1;
          o0.x = bflo(w.x) * rs * g[i][0].x; o0.y = bfhi(w.x) * rs * g[i][0].y; o0.z = bflo(w.y) * rs * g[i][0].z; o0.w = bfhi(w.y) * rs * g[i][0].w;
          o1.x = bflo(w.z) * rs * g[i][1].x; o1.y = bfhi(w.z) * rs * g[i][1].y; o1.z = bflo(w.w) * rs * g[i][1].z; o1.w = bfhi(w.w) * rs * g[i][1].w;
          *(float4*)(p.out + (size_t)r * 1024 + i * 512 + lane * 8) = o0;
          *(float4*)(p.out + (size_t)r * 1024 + i * 512 + lane * 8 + 4) = o1;
        }
      }
    }
  }
}

#define XB_TMO      128
#define XB_XCNT(j)  (256  + 64 * (j))
#define XB_XSUB(j)  (1280 + 64 * (j))
#define XB_XGEN(j)  (2304 + 64 * (j))
#define XB_TOP      3328
#define XB_TOPGEN   3392
#define XCD_BAR_WORDS 3456
#define XB_SPIN_CAP (1u << 18)
#define LAS __attribute__((address_space(3)))
DI unsigned xb_ld(unsigned* p) { return __hip_atomic_load(p, __ATOMIC_RELAXED, __HIP_MEMORY_SCOPE_AGENT); }
DI unsigned xb_add(unsigned* p, unsigned v) { return __hip_atomic_fetch_add(p, v, __ATOMIC_RELAXED, __HIP_MEMORY_SCOPE_AGENT); }
DI unsigned xb_xcc_id() { return (unsigned)__builtin_amdgcn_s_getreg((3 << 11) | 20) & 0xFu; }
#define XB_SPIN(cond, bar) do { unsigned _sp = 0; while (cond) { __builtin_amdgcn_s_sleep(1); \
    if ((++_sp & 255u) == 0u) { if (xb_ld(&(bar)[XB_TMO])) break; if (_sp > XB_SPIN_CAP) { atomicAdd(&(bar)[XB_TMO], 1u); break; } } } } while (0)
struct XcdBarrier { unsigned* bar; unsigned x; volatile LAS unsigned* st; };
DI XcdBarrier xcd_barrier_post(unsigned* bar, volatile LAS unsigned* st) {
  XcdBarrier b; b.bar = bar; b.x = xb_xcc_id(); b.st = st;
  if (threadIdx.x == 0) (void)xb_add(&bar[XB_XCNT(b.x)], 1u);
  return b;
}
DI void xcd_barrier_complete(unsigned* bar, unsigned x, unsigned& nloc, unsigned& nx) {
  const unsigned G = gridDim.x * gridDim.y * gridDim.z;
  unsigned sum, cnt, mine, sp = 0u;
  for (;;) {
    sum = 0u; cnt = 0u; mine = 0u;
#pragma unroll
    for (unsigned j = 0; j < 16; ++j) { const unsigned c = xb_ld(&bar[XB_XCNT(j)]); sum += c; cnt += (c > 0u) ? 1u : 0u; mine = (j == x) ? c : mine; }
    if (sum == G) break;
    __builtin_amdgcn_s_sleep(1);
    if ((++sp & 255u) == 0u) { if (xb_ld(&bar[XB_TMO])) break; if (sp > XB_SPIN_CAP) { atomicAdd(&bar[XB_TMO], 1u); break; } }
  }
  nloc = mine > 0u ? mine : 1u; nx = cnt > 0u ? cnt : 1u;
}
DI void xcd_barrier(const XcdBarrier& b) {
  asm volatile("s_waitcnt vmcnt(0)" ::: "memory");
  __syncthreads();
  if (threadIdx.x == 0) {
    unsigned* bar = b.bar;
    __builtin_amdgcn_s_waitcnt(0);
    unsigned nloc = b.st[0], nx = b.st[1];
    if (nloc == 0u) { xcd_barrier_complete(bar, b.x, nloc, nx); b.st[0] = nloc; b.st[1] = nx; }
    const unsigned old = xb_add(&bar[XB_XSUB(b.x)], 1u);
    const unsigned gen = old / nloc;
    if (old + 1u == (gen + 1u) * nloc) {
      __builtin_amdgcn_fence(__ATOMIC_RELEASE, "agent");
      asm volatile("s_waitcnt vmcnt(0)" ::: "memory");
      const unsigned og = xb_add(&bar[XB_TOP], 1u);
      const unsigned tg = og / nx;
      if (og + 1u == (tg + 1u) * nx) xb_add(&bar[XB_TOPGEN], 1u);
      else XB_SPIN(xb_ld(&bar[XB_TOPGEN]) == tg, bar);
      __builtin_amdgcn_fence(__ATOMIC_ACQUIRE, "agent");
      xb_add(&bar[XB_XGEN(b.x)], 1u);
      asm volatile("s_waitcnt vmcnt(0)" ::: "memory");
    } else {
      XB_SPIN(xb_ld(&bar[XB_XGEN(b.x)]) == gen, bar);
      __builtin_amdgcn_fence(__ATOMIC_ACQUIRE, "agent");
      asm volatile("s_waitcnt vmcnt(0)" ::: "memory");
    }
  }
  __syncthreads();
}

constexpr int NPHASE = 8;
#define PHASE_BEGIN(n) if (ph_lo <= (n) && (n) < ph_hi) { int g_tid = threadIdx.x, g_bid = blockIdx.x; asm volatile("" : "+v"(g_tid)); asm volatile("" : "+s"(g_bid));
#define PHASE_END(n) if ((n) + 1 < ph_hi) xcd_barrier(xb); }
__global__ void __launch_bounds__(256, 2) mega(Params p, int ph_lo, int ph_hi) {
  __shared__ __attribute__((aligned(16))) char smem[3 * G_STAGE + 64];
  __shared__ uint4 xb_words;
  cg::grid_group grid = cg::this_grid();
  if (ph_hi < 0) grid.sync();
  if (threadIdx.x == 0) xb_words = make_uint4(0u, 0u, 0u, 0u);
  __syncthreads();
  XcdBarrier xb = xcd_barrier_post(p.bar, (volatile LAS unsigned*)&xb_words);
  PHASE_BEGIN(0) phase_prepass(p, smem, g_tid, g_bid); PHASE_END(0)
  PHASE_BEGIN(1)
    {
      const int xcd = g_bid & 7, loc = g_bid >> 3, nloc = gridDim.x >> 3;
      const int nr1 = (272 + nloc - 1) / nloc; const bool stag = loc >= (nloc >> 1);
      for (int r = 0; r < nr1; ++r) {
        const int rr = stag ? (r + 3) % nr1 : r;
        const int j = loc + rr * nloc;
        if (j >= 272) continue;
        if (j < 192) gemm_tile<0, 8>(p, 0, xcd * 8 + (j & 7), j >> 3, smem, g_tid);
        else if (j < 256) { int jj = 192 + ((j - 192) >> 1), hf = j & 1; gemm_tile<0, 4>(p, 0, (xcd * 8 + (jj & 7)) * 2 + hf, jj >> 3, smem, g_tid); }
        else { int u = xcd * 16 + (j - 256); int layer = u >> 6, r = u & 63; gemm_tile<1, 4>(p, layer, r >> 2, r & 3, smem, g_tid); }
      }
    }
  PHASE_END(1)
  PHASE_BEGIN(2) phase_attn(p, 0, smem, g_tid, g_bid); PHASE_END(2)
  PHASE_BEGIN(3)
    {
      const int xcd = g_bid & 7, loc = g_bid >> 3, nloc = gridDim.x >> 3;
      for (int j = loc; j < 64; j += nloc) gemm_tile<2, 8>(p, 0, xcd * 8 + (j & 7), j >> 3, smem, g_tid);
    }
  PHASE_END(3)
  PHASE_BEGIN(4)
    {
      const int xcd = g_bid & 7, loc = g_bid >> 3, nloc = gridDim.x >> 3;
      const int nr4 = (256 + nloc - 1) / nloc; const bool stag = loc >= (nloc >> 1);
      for (int r = 0; r < nr4; ++r) {
        const int rr = stag ? (r + nr4 - 1) % nr4 : r;
        const int j = loc + rr * nloc;
        if (j >= 256) continue;
        if (j < 192) gemm_tile<0, 8>(p, 1, xcd * 8 + (j & 7), j >> 3, smem, g_tid);
        else { int jj = 192 + ((j - 192) >> 1), hf = j & 1; gemm_tile<0, 4>(p, 1, (xcd * 8 + (jj & 7)) * 2 + hf, jj >> 3, smem, g_tid); }
      }
    }
  PHASE_END(4)
  PHASE_BEGIN(5) phase_attn(p, 1, smem, g_tid, g_bid); PHASE_END(5)
  PHASE_BEGIN(6)
    {
      const int xcd = g_bid & 7, loc = g_bid >> 3, nloc = gridDim.x >> 3;
      for (int j = loc; j < 64; j += nloc) gemm_tile<2, 8>(p, 1, xcd * 8 + (j & 7), j >> 3, smem, g_tid);
    }
  PHASE_END(6)
  PHASE_BEGIN(7) phase_final(p, g_tid, g_bid); PHASE_END(7)
}

extern "C" void kernel_launch(void* const* d_in, const int* in_sizes, int n_in, void* d_out, int out_size, void* d_ws, size_t ws_size,
                              hipStream_t stream) {
  Params p{};
  p.x = (const float*)d_in[0]; p.mem = (const float*)d_in[1]; p.norm_g = (const float*)d_in[2]; p.w_in = (const float*)d_in[3];
  p.mem_norm_g = (const float*)d_in[4]; p.w_mem_kv = (const float*)d_in[5]; p.w_out = (const float*)d_in[6];
  p.final_g = (const float*)d_in[7];
  p.out = (float*)d_out;
  char* ws = (char*)d_ws;
  p.xb = (bf16_t*)(ws + 0);
  p.proj = (bf16_t*)(ws + 33554432ull);
  p.mixed = (bf16_t*)(ws + 150994944ull);
  p.wTin = (bf16_t*)(ws + 184549376ull);
  p.wTkv = (bf16_t*)(ws + 199229440ull);
  p.wTout = (bf16_t*)(ws + 201326592ull);
  p.memb = (bf16_t*)(ws + 205520896ull);
  p.mkv = (bf16_t*)(ws + 209715200ull);
  p.ss = (float*)(ws + 213909504ull);
  p.memss = (float*)(ws + 214106112ull);
  p.kmean = (float*)(ws + 214114304ull);
  p.costab = (float*)(ws + 214310912ull);
  p.sintab = (float*)(ws + 214376448ull);
  p.sbvT = (bf16_t*)(ws + 214441984ull);
  p.mbvT = (bf16_t*)(ws + 227024896ull);
  p.mvT = (bf16_t*)(ws + 239607808ull);
  p.bar = (unsigned*)(ws + 241704960ull);

  static int grid_blocks = 0;
  if (!grid_blocks) {
    int dev = 0, cus = 0, per_cu = 0;
    (void)hipGetDevice(&dev);
    (void)hipDeviceGetAttribute(&cus, hipDeviceAttributeMultiprocessorCount, dev);
    (void)hipOccupancyMaxActiveBlocksPerMultiprocessor(&per_cu, mega, 256, 0);
    if (per_cu > 2) per_cu = 2;
    if (per_cu < 1) per_cu = 1;
    grid_blocks = cus * per_cu;
  }
#if MULTI_LAUNCH
  for (int ph = 0; ph < NPHASE; ++ph) {
    if (NAIVE_ATTN && (ph == 2 || ph == 5)) {
      int layer = ph == 2 ? 0 : 1;
      hipLaunchKernelGGL(attn_naive_sb, dim3(384), dim3(256), 0, stream, p, layer);
      hipLaunchKernelGGL(attn_naive_moba, dim3(384), dim3(256), 0, stream, p, layer);
      hipLaunchKernelGGL(attn_naive_mem, dim3(256), dim3(256), 0, stream, p, layer);
    } else {
      hipLaunchKernelGGL(mega, dim3(grid_blocks), dim3(256), 0, stream, p, ph, ph + 1);
    }
  }
#else
  int lo = 0, hi = NPHASE;
  (void)hipMemsetAsync(p.bar, 0, (XCD_BAR_WORDS + 64) * sizeof(unsigned), stream);
  void* args[] = {&p, &lo, &hi};
  hipError_t e = hipLaunchCooperativeKernel((void*)mega, dim3(grid_blocks), dim3(256), args, 0, stream);
  if (e != hipSuccess) fprintf(stderr, "cooperative launch failed: %s (grid %d)\n", hipGetErrorString(e), grid_blocks);
#endif
}
```

```cpp
#include <hip/hip_runtime.h>
#include <hip/hip_cooperative_groups.h>
#include <stdint.h>
#include <cstdio>
namespace cg = cooperative_groups;

#ifndef MULTI_LAUNCH
#define MULTI_LAUNCH 0
#endif
#ifndef NAIVE_ATTN
#define NAIVE_ATTN 0
#endif

typedef unsigned short bf16_t;
using bf16x8 = __attribute__((ext_vector_type(8))) short;
using f32x4 = __attribute__((ext_vector_type(4))) float;
using u32x4 = __attribute__((ext_vector_type(4))) unsigned;
#define DI __device__ __forceinline__

constexpr int NB = 8, T = 2048, D = 1024, NTOK = NB * T, INC = 3584, MEML = 256, NMEM = NB * MEML;
constexpr int C_SBQ = 0, C_SBK = 384, C_SBV = 768, C_SBG = 1152, C_MBQ = 1536, C_MBK = 1920, C_MBV = 2304, C_MBG = 2688,
              C_MQ = 3072, C_MG = 3328;

struct Params {
  const float* x; const float* mem; const float* norm_g; const float* w_in; const float* mem_norm_g;
  const float* w_mem_kv; const float* w_out; const float* final_g;
  float* out;
  bf16_t* xb; bf16_t* proj; bf16_t* mixed; bf16_t* wTin; bf16_t* wTkv; bf16_t* wTout; bf16_t* memb; bf16_t* mkv;
  float* ss; float* memss; float* kmean; float* costab; float* sintab;
  bf16_t* sbvT; bf16_t* mbvT; bf16_t* mvT;
  unsigned* bar;
};

DI bf16_t f2bf(float x) { unsigned u = __float_as_uint(x); u += 0x7fffu + ((u >> 16) & 1u); return (bf16_t)(u >> 16); }
DI float bf2f(bf16_t b) { return __uint_as_float(((unsigned)b) << 16); }
DI float bflo(unsigned u) { return __uint_as_float(u << 16); }
DI float bfhi(unsigned u) { return __uint_as_float(u & 0xffff0000u); }
typedef float f32x2_t __attribute__((ext_vector_type(2)));
typedef __bf16 bf16x2_t __attribute__((ext_vector_type(2)));
DI unsigned pack2(float a, float b) { f32x2_t v = {a, b}; return __builtin_bit_cast(unsigned, __builtin_convertvector(v, bf16x2_t)); }
DI float4 ld_nt4(const float* ptr) { f32x4 t = __builtin_nontemporal_load((const f32x4*)ptr); return float4{t[0], t[1], t[2], t[3]}; }
DI float shfl16(float x) {
  const unsigned u = __float_as_uint(x);
  auto r = __builtin_amdgcn_permlane16_swap(u, u, false, false);
  return __uint_as_float((r[0] == u) ? r[1] : r[0]);
}
DI float shfl32(float x) {
  const unsigned u = __float_as_uint(x);
  auto r = __builtin_amdgcn_permlane32_swap(u, u, false, false);
  return __uint_as_float((r[0] == u) ? r[1] : r[0]);
}
DI float wave_sum(float v) {
#pragma unroll
  for (int o = 32; o >= 1; o >>= 1) v += __shfl_xor(v, o);
  return v;
}

DI void transpose_tile(const float* __restrict__ src, const float* __restrict__ g, bf16_t* __restrict__ dst, int N, int kt, int nt,
                       float* tile, int g_tid) {
  const int tid = g_tid;
  __syncthreads();
#pragma unroll
  for (int pss = 0; pss < 4; ++pss) {
    int kr = pss * 16 + (tid >> 4), nc = (tid & 15) * 4;
    int k = kt * 64 + kr;
    float4 v = ld_nt4(src + (size_t)k * N + nt * 64 + nc);
    float gs = g ? g[k] : 1.f;
    tile[kr * 65 + nc + 0] = v.x * gs; tile[kr * 65 + nc + 1] = v.y * gs;
    tile[kr * 65 + nc + 2] = v.z * gs; tile[kr * 65 + nc + 3] = v.w * gs;
  }
  __syncthreads();
#pragma unroll
  for (int pss = 0; pss < 2; ++pss) {
    int nr = pss * 32 + (tid >> 3), kc = (tid & 7) * 8;
    uint4 o;
    o.x = pack2(tile[(kc + 0) * 65 + nr], tile[(kc + 1) * 65 + nr]);
    o.y = pack2(tile[(kc + 2) * 65 + nr], tile[(kc + 3) * 65 + nr]);
    o.z = pack2(tile[(kc + 4) * 65 + nr], tile[(kc + 5) * 65 + nr]);
    o.w = pack2(tile[(kc + 6) * 65 + nr], tile[(kc + 7) * 65 + nr]);
    *(uint4*)(dst + (size_t)(nt * 64 + nr) * 1024 + kt * 64 + kc) = o;
  }
}

DI void row_convert(const float* __restrict__ src, bf16_t* __restrict__ dst, float* __restrict__ ssout, int row, int lane) {
  const float* r = src + (size_t)row * 1024;
  float s = 0.f;
#pragma unroll
  for (int i = 0; i < 2; ++i) {
    int c = i * 512 + lane * 8;
    float4 a = *(const float4*)(r + c), b = *(const float4*)(r + c + 4);
    s += a.x * a.x + a.y * a.y + a.z * a.z + a.w * a.w + b.x * b.x + b.y * b.y + b.z * b.z + b.w * b.w;
    uint4 o; o.x = pack2(a.x, a.y); o.y = pack2(a.z, a.w); o.z = pack2(b.x, b.y); o.w = pack2(b.z, b.w);
    *(uint4*)(dst + (size_t)row * 1024 + c) = o;
  }
  s = wave_sum(s);
  if (lane == 0) ssout[row] = s;
}

DI void phase_prepass(const Params& p, char* smem, int g_tid, int g_bid) {
  const int tid = g_tid, lane = tid & 63, wid = tid >> 6;
  const int gtid = g_bid * 256 + tid, gth = gridDim.x * 256;
  for (int i = gtid; i < 2 * 8 * 8 * 384; i += gth) p.kmean[i] = 0.f;
  for (int i = gtid; i < 2 * NTOK; i += gth) p.ss[NTOK + i] = 0.f;
  for (int i = gtid; i < T * 8; i += gth) {
    int pos = i >> 3, f = i & 7;
    const float invf[8] = {1.000000000e+00f, 1.939227447e-01f, 3.760603093e-02f, 7.292664737e-03f, 1.414213562e-03f, 2.742481757e-04f, 5.318295897e-05f, 1.031338538e-05f};
    float inv = invf[0];
#pragma unroll
    for (int q = 1; q < 8; ++q) inv = (f == q) ? invf[q] : inv;
    float ang = (float)pos * inv;
    p.costab[i] = cosf(ang); p.sintab[i] = sinf(ang);
  }
  const int NT_IN = 16 * 56, NT_KV = 16 * 8, NT_OUT = 16 * 16;
  const int per_layer = NT_IN + NT_KV + NT_OUT;
  for (int job = g_bid; job < 2 * per_layer; job += gridDim.x) {
    int layer = job / per_layer, j = job % per_layer;
    if (j < NT_IN) {
      transpose_tile(p.w_in + (size_t)layer * 1024 * INC, p.norm_g + layer * 1024, p.wTin + (size_t)layer * INC * 1024, INC, j / 56, j % 56,
                     (float*)smem, g_tid);
    } else if (j < NT_IN + NT_KV) {
      j -= NT_IN;
      transpose_tile(p.w_mem_kv + (size_t)layer * 1024 * 512, p.mem_norm_g + layer * 1024, p.wTkv + (size_t)layer * 512 * 1024, 512, j / 8,
                     j % 8, (float*)smem, g_tid);
    } else {
      j -= NT_IN + NT_KV;
      transpose_tile(p.w_out + (size_t)layer * 1024 * 1024, nullptr, p.wTout + (size_t)layer * 1024 * 1024, 1024, j / 16, j % 16,
                     (float*)smem, g_tid);
    }
  }
  {
    const int stride = gridDim.x * 4;
    for (int r0 = g_bid * 4 + wid; r0 < NTOK + NMEM; r0 += 3 * stride) {
      float4 va[3][4];
#pragma unroll
      for (int u = 0; u < 3; ++u) {
        const int r = r0 + u * stride;
        if (r < NTOK + NMEM) {
          const float* rp = (r < NTOK) ? p.x + (size_t)r * 1024 : p.mem + (size_t)(r - NTOK) * 1024;
#pragma unroll
          for (int i = 0; i < 2; ++i) { va[u][2 * i] = ld_nt4(rp + i * 512 + lane * 8); va[u][2 * i + 1] = ld_nt4(rp + i * 512 + lane * 8 + 4); }
        }
      }
#pragma unroll
      for (int u = 0; u < 3; ++u) {
        const int r = r0 + u * stride;
        if (r < NTOK + NMEM) {
          bf16_t* dp = (r < NTOK) ? p.xb + (size_t)r * 1024 : p.memb + (size_t)(r - NTOK) * 1024;
          float sacc = 0.f;
#pragma unroll
          for (int i = 0; i < 2; ++i) {
            const float4 a = va[u][2 * i], b = va[u][2 * i + 1];
            sacc += a.x * a.x + a.y * a.y + a.z * a.z + a.w * a.w + b.x * b.x + b.y * b.y + b.z * b.z + b.w * b.w;
            uint4 o; o.x = pack2(a.x, a.y); o.y = pack2(a.z, a.w); o.z = pack2(b.x, b.y); o.w = pack2(b.z, b.w);
            *(uint4*)(dp + i * 512 + lane * 8) = o;
          }
          sacc = wave_sum(sacc);
          if (lane == 0) { if (r < NTOK) p.ss[r] = sacc; else p.memss[r - NTOK] = sacc; }
        }
      }
    }
  }
}

constexpr int LDS_STR = 72;
constexpr int G_STAGE = (256 + 128) * 64;

template <int MODE, int MT>
DI void gemm_tile(const Params& p, int layer, int mt, int nt, char* smem, int g_tid) {
  const int tid = g_tid, lane = tid & 63, wid = tid >> 6, wr = wid >> 1, wc = wid & 1;
  const int fr = lane & 15, fq = lane >> 4;
  const bf16_t* A; const bf16_t* Bt;
  if (MODE == 0) { A = p.xb; Bt = p.wTin + (size_t)layer * INC * 1024; }
  else if (MODE == 1) { A = p.memb; Bt = p.wTkv + (size_t)layer * 512 * 1024; }
  else { A = p.mixed; Bt = p.wTout + (size_t)layer * 1024 * 1024; }
  const bf16_t* Ag = A + (size_t)(mt * (MT * 32)) * 1024;
  const bf16_t* Bg = Bt + (size_t)(nt * 128) * 1024;
  f32x4 acc[MT][4];
#pragma unroll
  for (int m = 0; m < MT; ++m)
#pragma unroll
    for (int n = 0; n < 4; ++n) acc[m][n] = f32x4{0.f, 0.f, 0.f, 0.f};
  constexpr int NLD = (MT == 8) ? 6 : 4;
  u32x4 rgA[NLD], rgB[NLD];
  const unsigned goff0 = (unsigned)((tid >> 2) * 2048 + (((tid & 3) ^ (((tid >> 5) & 1) * 3)) * 16));
  const int sbase = tid * 16;
  const char* Ab = (const char*)Ag; const char* Bb = (const char*)Bg;
#define G_LOAD(R, KT) _Pragma("unroll") for (int i = 0; i < NLD; ++i) { \
    const int ii = (MT == 8) ? i : (i < 2 ? i : i + 2); \
    const char* gb = ((ii < 4) ? Ab + ii * 131072 : Bb + (ii - 4) * 131072) + (KT) * 64; \
    R[i] = *(const u32x4*)(gb + goff0); }
#define G_STORE(R, ST) _Pragma("unroll") for (int i = 0; i < NLD; ++i) { \
    const int ii = (MT == 8) ? i : (i < 2 ? i : i + 2); \
    *(u32x4*)((ST) + ii * 4096 + sbase) = R[i]; }
#define G_COMPUTE(ST) { const char* st = (ST); bf16x8 b[4]; \
    _Pragma("unroll") for (int n = 0; n < 4; ++n) b[n] = *(const bf16x8*)(st + boff + (n >> 1) * 2048 + (n & 1) * 256); \
    _Pragma("unroll") for (int mh = 0; mh < MT; mh += 4) { bf16x8 a[4]; \
      _Pragma("unroll") for (int m = 0; m < 4; ++m) a[m] = *(const bf16x8*)(st + aoff + (mh + m) * 1024); \
      __builtin_amdgcn_s_setprio(1); \
      _Pragma("unroll") for (int m = 0; m < 4; ++m) \
        _Pragma("unroll") for (int n = 0; n < 4; ++n) acc[mh + m][n] = __builtin_amdgcn_mfma_f32_16x16x32_bf16(b[n], a[m], acc[mh + m][n], 0, 0, 0); \
      __builtin_amdgcn_s_setprio(0); } }
  const int aoff = (wr * (MT * 16) + fr) * 64 + ((fq ^ (((fr >> 3) & 1) * 3)) & 3) * 16;
  const int boff = 16384 + (wc * 64 + 8 * (fr >> 2) + (fr & 3)) * 64 + ((fq ^ (((fr >> 2) & 1) * 3)) & 3) * 16;
  G_LOAD(rgA, 0)
  G_STORE(rgA, smem)
  G_LOAD(rgA, 1)
  G_LOAD(rgB, 2)
#pragma unroll 1
  for (int kt = 0; kt < 32; kt += 2) {
    __syncthreads();
    G_STORE(rgA, smem + G_STAGE)
    if (kt + 3 < 32) G_LOAD(rgA, kt + 3)
    G_COMPUTE(smem)
    __syncthreads();
    if (kt + 2 < 32) G_STORE(rgB, smem)
    if (kt + 4 < 32) G_LOAD(rgB, kt + 4)
    G_COMPUTE(smem + G_STAGE)
  }
#undef G_LOAD
#undef G_STORE
#undef G_COMPUTE
  const int cb = nt * 128 + wc * 64;
  const int rb0 = mt * (MT * 32) + wr * (MT * 16);
  if (MODE == 0) {
    const bool rot = (cb >= C_MBQ && cb < C_MBV);
    const bool km = (cb >= C_MBK && cb < C_MBV);
    f32x4 colsum[4];
#pragma unroll
    for (int n = 0; n < 4; ++n) colsum[n] = f32x4{0.f, 0.f, 0.f, 0.f};
    float rsv[MT];
#pragma unroll
    for (int m = 0; m < MT; ++m) rsv[m] = p.ss[layer * NTOK + rb0 + m * 16 + fr];
#pragma unroll
    for (int m = 0; m < MT; ++m) rsv[m] = rsqrtf(rsv[m] * (1.f / 1024.f) + 1e-6f);
#pragma unroll
    for (int m = 0; m < MT; ++m) {
      const int grow = rb0 + m * 16 + fr;
      const float rs = rsv[m];
#pragma unroll
      for (int pp = 0; pp < 2; ++pp) {
        f32x4 v0 = acc[m][2 * pp] * rs, v1 = acc[m][2 * pp + 1] * rs;
        if (pp == 0 && rot) {
          const int pos = grow & (T - 1);
          const float4 c0 = *(const float4*)(p.costab + pos * 8), c1 = *(const float4*)(p.costab + pos * 8 + 4);
          const float4 s0 = *(const float4*)(p.sintab + pos * 8), s1 = *(const float4*)(p.sintab + pos * 8 + 4);
          const float cc[8] = {c0.x, c0.y, c0.z, c0.w, c1.x, c1.y, c1.z, c1.w};
          const float sn[8] = {s0.x, s0.y, s0.z, s0.w, s1.x, s1.y, s1.z, s1.w};
#pragma unroll
          for (int j = 0; j < 4; ++j) {
            const float p0 = shfl16(v0[j]), p1 = shfl16(v1[j]);
            const float r0 = (fq == 0) ? (v0[j] * cc[j] - p0 * sn[j]) : (v0[j] * cc[j] + p0 * sn[j]);
            const float r1 = (fq == 0) ? (v1[j] * cc[4 + j] - p1 * sn[4 + j]) : (v1[j] * cc[4 + j] + p1 * sn[4 + j]);
            v0[j] = (fq < 2) ? r0 : v0[j];
            v1[j] = (fq < 2) ? r1 : v1[j];
          }
        }
        if (km) { colsum[2 * pp] += v0; colsum[2 * pp + 1] += v1; }
        uint4 o; o.x = pack2(v0[0], v0[1]); o.y = pack2(v0[2], v0[3]); o.z = pack2(v1[0], v1[1]); o.w = pack2(v1[2], v1[3]);
        *(uint4*)(p.proj + (size_t)grow * INC + cb + pp * 32 + fq * 8) = o;
      }
      if (m & 1) asm volatile("" ::: "memory");
    }
    if (km) {
      const int b = rb0 / T, blk = (rb0 % T) / 256;
#pragma unroll
      for (int n = 0; n < 4; ++n)
#pragma unroll
        for (int j = 0; j < 4; ++j) {
          float sm = colsum[n][j];
          sm += __shfl_xor(sm, 1); sm += __shfl_xor(sm, 2); sm += __shfl_xor(sm, 4); sm += __shfl_xor(sm, 8);
          if (fr == 0) atomicAdd(&p.kmean[((layer * 8 + b) * 8 + blk) * 384 + (cb - C_MBK) + (n >> 1) * 32 + fq * 8 + (n & 1) * 4 + j], sm);
        }
    }
  } else if (MODE == 1) {
    float rsv[MT];
#pragma unroll
    for (int m = 0; m < MT; ++m) rsv[m] = p.memss[rb0 + m * 16 + fr];
#pragma unroll
    for (int m = 0; m < MT; ++m) rsv[m] = rsqrtf(rsv[m] * (1.f / 1024.f) + 1e-6f);
#pragma unroll
    for (int m = 0; m < MT; ++m) {
      const int grow = rb0 + m * 16 + fr;
#pragma unroll
      for (int pp = 0; pp < 2; ++pp) {
        f32x4 v0 = acc[m][2 * pp] * rsv[m], v1 = acc[m][2 * pp + 1] * rsv[m];
        uint4 o; o.x = pack2(v0[0], v0[1]); o.y = pack2(v0[2], v0[3]); o.z = pack2(v1[0], v1[1]); o.w = pack2(v1[2], v1[3]);
        *(uint4*)(p.mkv + (size_t)layer * NMEM * 512 + (size_t)grow * 512 + cb + pp * 32 + fq * 8) = o;
      }
      if (m & 1) asm volatile("" ::: "memory");
    }
  } else {
    if (layer == 0) {
#pragma unroll
      for (int mp = 0; mp < MT / 2; ++mp) {
        uint4 xo[2][2];
#pragma unroll
        for (int h2 = 0; h2 < 2; ++h2)
#pragma unroll
          for (int pp = 0; pp < 2; ++pp)
            xo[h2][pp] = *(const uint4*)(p.xb + (size_t)(rb0 + (mp * 2 + h2) * 16 + fr) * 1024 + cb + pp * 32 + fq * 8);
#pragma unroll
        for (int h2 = 0; h2 < 2; ++h2) {
          const int m = mp * 2 + h2;
          const int grow = rb0 + m * 16 + fr;
          float sq = 0.f;
#pragma unroll
          for (int pp = 0; pp < 2; ++pp) {
            const size_t idx = (size_t)grow * 1024 + cb + pp * 32 + fq * 8;
            const uint4 u = xo[h2][pp];
            float4 xa, xc;
            xa.x = bflo(u.x) + acc[m][2 * pp][0]; xa.y = bfhi(u.x) + acc[m][2 * pp][1];
            xa.z = bflo(u.y) + acc[m][2 * pp][2]; xa.w = bfhi(u.y) + acc[m][2 * pp][3];
            xc.x = bflo(u.z) + acc[m][2 * pp + 1][0]; xc.y = bfhi(u.z) + acc[m][2 * pp + 1][1];
            xc.z = bflo(u.w) + acc[m][2 * pp + 1][2]; xc.w = bfhi(u.w) + acc[m][2 * pp + 1][3];
            uint4 o; o.x = pack2(xa.x, xa.y); o.y = pack2(xa.z, xa.w); o.z = pack2(xc.x, xc.y); o.w = pack2(xc.z, xc.w);
            *(uint4*)(p.xb + idx) = o;
            sq += xa.x * xa.x + xa.y * xa.y + xa.z * xa.z + xa.w * xa.w + xc.x * xc.x + xc.y * xc.y + xc.z * xc.z + xc.w * xc.w;
          }
          sq += shfl16(sq); sq += shfl32(sq);
          if (fq == 0) atomicAdd(&p.ss[NTOK + grow], sq);
        }
        asm volatile("" ::: "memory");
      }
    } else {
#pragma unroll
      for (int mp = 0; mp < MT / 2; ++mp) {
        uint4 xo[2][2];
#pragma unroll
        for (int h2 = 0; h2 < 2; ++h2)
#pragma unroll
          for (int pp = 0; pp < 2; ++pp)
            xo[h2][pp] = *(const uint4*)(p.xb + (size_t)(rb0 + (mp * 2 + h2) * 16 + fr) * 1024 + cb + pp * 32 + fq * 8);
#pragma unroll
        for (int h2 = 0; h2 < 2; ++h2) {
          const int m = mp * 2 + h2;
          const int grow = rb0 + m * 16 + fr;
          float sq = 0.f;
#pragma unroll
          for (int pp = 0; pp < 2; ++pp) {
            const size_t idx = (size_t)grow * 1024 + cb + pp * 32 + fq * 8;
            const uint4 u = xo[h2][pp];
            float4 xa, xc;
            xa.x = bflo(u.x) + acc[m][2 * pp][0]; xa.y = bfhi(u.x) + acc[m][2 * pp][1];
            xa.z = bflo(u.y) + acc[m][2 * pp][2]; xa.w = bfhi(u.y) + acc[m][2 * pp][3];
            xc.x = bflo(u.z) + acc[m][2 * pp + 1][0]; xc.y = bfhi(u.z) + acc[m][2 * pp + 1][1];
            xc.z = bflo(u.w) + acc[m][2 * pp + 1][2]; xc.w = bfhi(u.w) + acc[m][2 * pp + 1][3];
            { uint4 o; o.x = pack2(xa.x, xa.y); o.y = pack2(xa.z, xa.w); o.z = pack2(xc.x, xc.y); o.w = pack2(xc.z, xc.w);
              *(uint4*)(p.xb + idx) = o; }
            sq += xa.x * xa.x + xa.y * xa.y + xa.z * xa.z + xa.w * xa.w + xc.x * xc.x + xc.y * xc.y + xc.z * xc.z + xc.w * xc.w;
          }
          sq += shfl16(sq); sq += shfl32(sq);
          if (fq == 0) atomicAdd(&p.ss[2 * NTOK + grow], sq);
        }
        asm volatile("" ::: "memory");
      }
    }
  }
}

DI void load_row64(const bf16_t* __restrict__ ptr, float (&r)[64], float scale) {
#pragma unroll
  for (int i = 0; i < 8; ++i) {
    uint4 u = *(const uint4*)(ptr + i * 8);
    r[i * 8 + 0] = bflo(u.x) * scale; r[i * 8 + 1] = bfhi(u.x) * scale;
    r[i * 8 + 2] = bflo(u.y) * scale; r[i * 8 + 3] = bfhi(u.y) * scale;
    r[i * 8 + 4] = bflo(u.z) * scale; r[i * 8 + 5] = bfhi(u.z) * scale;
    r[i * 8 + 6] = bflo(u.w) * scale; r[i * 8 + 7] = bfhi(u.w) * scale;
  }
}
DI float dot_row64(const bf16_t* __restrict__ ptr, const float (&q)[64]) {
  float z = 0.f;
#pragma unroll
  for (int i = 0; i < 8; ++i) {
    uint4 u = *(const uint4*)(ptr + i * 8);
    z += q[i * 8 + 0] * bflo(u.x); z += q[i * 8 + 1] * bfhi(u.x);
    z += q[i * 8 + 2] * bflo(u.y); z += q[i * 8 + 3] * bfhi(u.y);
    z += q[i * 8 + 4] * bflo(u.z); z += q[i * 8 + 5] * bfhi(u.z);
    z += q[i * 8 + 6] * bflo(u.w); z += q[i * 8 + 7] * bfhi(u.w);
  }
  return z;
}
DI void axpy_row64(const bf16_t* __restrict__ ptr, float w, float (&acc)[64]) {
#pragma unroll
  for (int i = 0; i < 8; ++i) {
    uint4 u = *(const uint4*)(ptr + i * 8);
    acc[i * 8 + 0] += w * bflo(u.x); acc[i * 8 + 1] += w * bfhi(u.x);
    acc[i * 8 + 2] += w * bflo(u.y); acc[i * 8 + 3] += w * bfhi(u.y);
    acc[i * 8 + 4] += w * bflo(u.z); acc[i * 8 + 5] += w * bfhi(u.z);
    acc[i * 8 + 6] += w * bflo(u.w); acc[i * 8 + 7] += w * bfhi(u.w);
  }
}
DI void gate_store(const bf16_t* __restrict__ gp, bf16_t* __restrict__ op, const float (&acc)[64], float scale) {
#pragma unroll
  for (int i = 0; i < 8; ++i) {
    uint4 u = *(const uint4*)(gp + i * 8);
    float g[8] = {bflo(u.x), bfhi(u.x), bflo(u.y), bfhi(u.y), bflo(u.z), bfhi(u.z), bflo(u.w), bfhi(u.w)};
    float o[8];
#pragma unroll
    for (int e = 0; e < 8; ++e) o[e] = acc[i * 8 + e] * scale * (g[e] / (1.f + __expf(-g[e])));
    uint4 w; w.x = pack2(o[0], o[1]); w.y = pack2(o[2], o[3]); w.z = pack2(o[4], o[5]); w.w = pack2(o[6], o[7]);
    *(uint4*)(op + i * 8) = w;
  }
}

DI void sb_naive_wave(const Params& p, int layer, int item, int lane) {
  const int qc = 31 - (item & 31), bh = item >> 5, h = bh % 6, b = bh / 6;
  const int t = qc * 64 + lane;
  const bf16_t* base = p.proj + (size_t)(b * T) * INC;
  float q[64], acc[64];
  load_row64(base + (size_t)t * INC + C_SBQ + h * 64, q, 0.125f);
#pragma unroll
  for (int d = 0; d < 64; ++d) acc[d] = 0.f;
  float carry = 0.f;
  for (int s = qc * 64 + 62; s >= 0; --s) {
    const bf16_t* kp = base + (size_t)s * INC + C_SBK + h * 64;
    float z = dot_row64(kp, q);
    bool act = s < t;
    float lb = fminf(z, 0.f) - log1pf(expf(-fabsf(z)));
    float w = act ? expf(lb + carry) : 0.f;
    carry += act ? (lb - z) : 0.f;
    axpy_row64(kp + (C_SBV - C_SBK), w, acc);
  }
  gate_store(base + (size_t)t * INC + C_SBG + h * 64, p.mixed + (size_t)(b * T + t) * 1024 + h * 64, acc, 1.f);
}

DI void os_step(const float (&q)[64], float& m, float& l, float (&acc)[64], const bf16_t* kp, const bf16_t* vp, bool valid) {
  float sc = dot_row64(kp, q);
  sc = valid ? sc : -1e30f;
  float mn = fmaxf(m, sc);
  float alpha = __expf(m - mn);
  float pw = valid ? __expf(sc - mn) : 0.f;
  l = l * alpha + pw;
  m = mn;
#pragma unroll
  for (int d = 0; d < 64; ++d) acc[d] *= alpha;
  axpy_row64(vp, pw, acc);
}

DI void moba_naive_wave(const Params& p, int layer, int item, int lane) {
  const int qc = 31 - (item & 31), bh = item >> 5, h = bh % 6, b = bh / 6;
  const int t = qc * 64 + lane, own = qc >> 2;
  const bf16_t* base = p.proj + (size_t)(b * T) * INC;
  float q[64], acc[64];
  load_row64(base + (size_t)t * INC + C_MBQ + h * 64, q, 1.f);
  unsigned sel = 0;
  if (own <= 3) sel = (1u << own) - 1u;
  else {
    float gate[8];
#pragma unroll
    for (int j = 0; j < 8; ++j) {
      float gsum = 0.f;
      if (j < own) {
        const float* km = p.kmean + ((layer * 8 + b) * 8 + j) * 384 + h * 64;
#pragma unroll
        for (int d = 0; d < 64; ++d) gsum += q[d] * km[d];
      }
      gate[j] = gsum;
    }
#pragma unroll
    for (int r = 0; r < 3; ++r) {
      float best = -3.0e38f; int bi = 0;
#pragma unroll
      for (int j = 0; j < 8; ++j) {
        bool ok = (j < own) && !((sel >> j) & 1u) && (gate[j] > best);
        best = ok ? gate[j] : best; bi = ok ? j : bi;
      }
      sel |= 1u << bi;
    }
  }
#pragma unroll
  for (int d = 0; d < 64; ++d) { acc[d] = 0.f; q[d] *= 0.125f; }
  float m = -1e30f, l = 0.f;
  for (int j = 0; j < own; ++j) {
    bool v = (sel >> j) & 1u;
    if (__ballot(v) == 0ull) continue;
    for (int s = j * 256; s < j * 256 + 256; ++s) {
      const bf16_t* kp = base + (size_t)s * INC + C_MBK + h * 64;
      os_step(q, m, l, acc, kp, kp + (C_MBV - C_MBK), v);
    }
  }
  for (int s = own * 256; s <= qc * 64 + 63; ++s) {
    const bf16_t* kp = base + (size_t)s * INC + C_MBK + h * 64;
    os_step(q, m, l, acc, kp, kp + (C_MBV - C_MBK), s <= t);
  }
  gate_store(base + (size_t)t * INC + C_MBG + h * 64, p.mixed + (size_t)(b * T + t) * 1024 + 384 + h * 64, acc, 1.f / l);
}

DI void mem_naive_wave(const Params& p, int layer, int item, int lane) {
  const int qc = item & 31, bh = item >> 5, h = bh & 3, b = bh >> 2;
  const int t = qc * 64 + lane;
  const bf16_t* base = p.proj + (size_t)(b * T) * INC;
  float q[64], acc[64];
  load_row64(base + (size_t)t * INC + C_MQ + h * 64, q, 0.125f);
#pragma unroll
  for (int d = 0; d < 64; ++d) acc[d] = 0.f;
  float m = -1e30f, l = 0.f;
  const bf16_t* kv = p.mkv + (size_t)layer * NMEM * 512 + (size_t)(b * MEML) * 512 + h * 64;
  for (int s = 0; s < MEML; ++s) os_step(q, m, l, acc, kv + (size_t)s * 512, kv + (size_t)s * 512 + 256, true);
  gate_store(base + (size_t)t * INC + C_MG + h * 64, p.mixed + (size_t)(b * T + t) * 1024 + 768 + h * 64, acc, 1.f / l);
}

__global__ void __launch_bounds__(256) attn_naive_sb(Params p, int layer) {
  sb_naive_wave(p, layer, blockIdx.x * 4 + (threadIdx.x >> 6), threadIdx.x & 63);
}
__global__ void __launch_bounds__(256) attn_naive_moba(Params p, int layer) {
  moba_naive_wave(p, layer, blockIdx.x * 4 + (threadIdx.x >> 6), threadIdx.x & 63);
}
__global__ void __launch_bounds__(256) attn_naive_mem(Params p, int layer) {
  mem_naive_wave(p, layer, blockIdx.x * 4 + (threadIdx.x >> 6), threadIdx.x & 63);
}

constexpr int AT_STR = 72;
constexpr float C2 = 0.125f * 1.4426950408889634f;

DI bf16x8 pack8(const f32x4& a, const f32x4& b) {
  u32x4 r;
  r[0] = pack2(a[0], a[1]); r[1] = pack2(a[2], a[3]); r[2] = pack2(b[0], b[1]); r[3] = pack2(b[2], b[3]);
  return __builtin_bit_cast(bf16x8, r);
}

struct TileSrc { const bf16_t* k; int kstride; const bf16_t* v; };

DI void tile_gload(const TileSrc& ts, int k0, int tid, u32x4 (&rk)[2], u32x4 (&rv)[2]) {
  const unsigned toff = (unsigned)((tid >> 3) * ts.kstride * 2 + (tid & 7) * 16);
#pragma unroll
  for (int i = 0; i < 2; ++i) {
    const char* kb = (const char*)ts.k + (size_t)(k0 + 32 * i) * ts.kstride * 2;
    const char* vb = (const char*)ts.v + (size_t)(k0 + 32 * i) * ts.kstride * 2;
    rk[i] = *(const u32x4*)(kb + toff);
    rv[i] = *(const u32x4*)(vb + toff);
  }
}
DI void tile_sstore(bf16_t* Ks, bf16_t* Vs, int tid, const u32x4 (&rk)[2], const u32x4 (&rv)[2]) {
#pragma unroll
  for (int i = 0; i < 2; ++i) {
    int c = tid + i * 256, row = c >> 3, ch = c & 7;
    int kk = row & 31;
    int rho = (row & 32) + ((kk >> 2) & 1) * 16 + (kk >> 3) * 4 + (kk & 3);
    *(u32x4*)(Ks + rho * AT_STR + ch * 8) = rk[i];
    *(u32x4*)(Vs + row * AT_STR + ch * 8) = rv[i];
  }
}

DI void st_mfma(const bf16_t* Ks, const bf16x8 (&qf)[2], f32x4 (&s)[4], int fr, int fq) {
#pragma unroll
  for (int i = 0; i < 4; ++i) {
    bf16x8 a0 = *(const bf16x8*)(Ks + (i * 16 + fr) * AT_STR + fq * 8);
    bf16x8 a1 = *(const bf16x8*)(Ks + (i * 16 + fr) * AT_STR + 32 + fq * 8);
    f32x4 z = {0.f, 0.f, 0.f, 0.f};
    z = __builtin_amdgcn_mfma_f32_16x16x32_bf16(a0, qf[0], z, 0, 0, 0);
    z = __builtin_amdgcn_mfma_f32_16x16x32_bf16(a1, qf[1], z, 0, 0, 0);
    s[i] = z;
  }
}
typedef short s16x4_t __attribute__((ext_vector_type(4)));
DI void pv_mfma(const bf16_t* Vs, const bf16x8 (&pw)[2][2], f32x4 (&o)[2][4], int fr, int fq) {
  const int q = fr >> 2, pp = fr & 3;
#pragma unroll
  for (int dt = 0; dt < 4; ++dt) {
#pragma unroll
    for (int st = 0; st < 2; ++st) {
      const bf16_t* a0p = Vs + (st * 32 + fq * 8 + q) * AT_STR + dt * 16 + 4 * pp;
      s16x4_t lo = __builtin_amdgcn_ds_read_tr16_b64_v4i16((__attribute__((address_space(3))) s16x4_t*)(a0p));
      s16x4_t hi = __builtin_amdgcn_ds_read_tr16_b64_v4i16((__attribute__((address_space(3))) s16x4_t*)(a0p + 4 * AT_STR));
      bf16x8 a = __builtin_shufflevector(lo, hi, 0, 1, 2, 3, 4, 5, 6, 7);
#pragma unroll
      for (int qg = 0; qg < 2; ++qg) o[qg][dt] = __builtin_amdgcn_mfma_f32_16x16x32_bf16(a, pw[qg][st], o[qg][dt], 0, 0, 0);
    }
  }
}

template <int KIND>
DI void attn_item(const Params& p, int layer, int item, char* smem, int g_tid) {
  const int tid = g_tid, lane = tid & 63, wid = tid >> 6, fr = lane & 15, fq = lane >> 4;
  bf16_t* Ksb[2]; bf16_t* Vsb[2];
  Ksb[0] = (bf16_t*)smem; Vsb[0] = Ksb[0] + 64 * AT_STR; Ksb[1] = Vsb[0] + 64 * AT_STR; Vsb[1] = Ksb[1] + 64 * AT_STR;
  unsigned* sU = (unsigned*)(smem + 4 * 64 * AT_STR * 2);
  int b, h, qt;
  const bf16_t *qbase, *gbase; bf16_t* obase; TileSrc ts;
  if (KIND == 0) {
    qt = 15 - (item & 15); int bh = item >> 4; h = bh % 6; b = bh / 6;
    const bf16_t* pb = p.proj + (size_t)(b * T) * INC;
    qbase = pb + C_SBQ + h * 64; gbase = pb + C_SBG + h * 64; ts.k = pb + C_SBK + h * 64; ts.kstride = INC;
    ts.v = pb + C_SBV + h * 64;
    obase = p.mixed + (size_t)(b * T) * 1024 + h * 64;
  } else if (KIND == 1) {
    qt = 15 - (item & 15); int bh = item >> 4; h = bh % 6; b = bh / 6;
    const bf16_t* pb = p.proj + (size_t)(b * T) * INC;
    qbase = pb + C_MBQ + h * 64; gbase = pb + C_MBG + h * 64; ts.k = pb + C_MBK + h * 64; ts.kstride = INC;
    ts.v = pb + C_MBV + h * 64;
    obase = p.mixed + (size_t)(b * T) * 1024 + 384 + h * 64;
  } else {
    qt = item & 15; int bh = item >> 4; h = bh & 3; b = bh >> 2;
    const bf16_t* pb = p.proj + (size_t)(b * T) * INC;
    qbase = pb + C_MQ + h * 64; gbase = pb + C_MG + h * 64;
    ts.k = p.mkv + (size_t)layer * NMEM * 512 + (size_t)(b * MEML) * 512 + h * 64; ts.kstride = 512;
    ts.v = ts.k + 256;
    obase = p.mixed + (size_t)(b * T) * 1024 + 768 + h * 64;
  }
  const int q0 = qt * 128;
  const int tmin = q0 + wid * 32, tmax = tmin + 31;
  bf16x8 qf[2][2];
#pragma unroll
  for (int qg = 0; qg < 2; ++qg)
#pragma unroll
    for (int ks = 0; ks < 2; ++ks)
      qf[qg][ks] = *(const bf16x8*)(qbase + (size_t)(tmin + qg * 16 + fr) * INC + ks * 32 + fq * 8);

  const int own = q0 >> 8, own_start = own << 8;
  u32x4 rk[2], rv[2], rk2[2], rv2[2];
  tile_gload(ts, KIND == 0 ? ((q0 >> 6) + 1) * 64 : (KIND == 1 ? own_start : 0), tid, rk, rv);
  int ntile; unsigned U = 0; int n_own = 0;
  unsigned sel[2] = {0u, 0u};
  if (KIND == 0) ntile = (q0 >> 6) + 2;
  else if (KIND == 2) ntile = 4;
  else {
    n_own = ((q0 - own_start) >> 6) + 2;
    if (own <= 3) { U = (1u << own) - 1u; sel[0] = sel[1] = U; }
    else {
      f32x4 ga[2];
      ga[0] = f32x4{0.f, 0.f, 0.f, 0.f}; ga[1] = ga[0];
#pragma unroll
      for (int ks = 0; ks < 2; ++ks) {
        float kmv[8];
        const float* kmp = p.kmean + (size_t)((layer * 8 + b) * 8 + (fr & 7)) * 384 + h * 64 + ks * 32 + fq * 8;
        float4 k0v = *(const float4*)kmp, k1v = *(const float4*)(kmp + 4);
        kmv[0] = k0v.x; kmv[1] = k0v.y; kmv[2] = k0v.z; kmv[3] = k0v.w; kmv[4] = k1v.x; kmv[5] = k1v.y; kmv[6] = k1v.z; kmv[7] = k1v.w;
        u32x4 hi, lo;
#pragma unroll
        for (int e = 0; e < 4; ++e) {
          float x0 = (fr < 8) ? kmv[2 * e] : 0.f, x1 = (fr < 8) ? kmv[2 * e + 1] : 0.f;
          bf16_t h0 = f2bf(x0), h1 = f2bf(x1);
          hi[e] = (unsigned)h0 | ((unsigned)h1 << 16);
          lo[e] = pack2(x0 - bf2f(h0), x1 - bf2f(h1));
        }
        bf16x8 ah = __builtin_bit_cast(bf16x8, hi), al = __builtin_bit_cast(bf16x8, lo);
#pragma unroll
        for (int qg = 0; qg < 2; ++qg) {
          ga[qg] = __builtin_amdgcn_mfma_f32_16x16x32_bf16(ah, qf[qg][ks], ga[qg], 0, 0, 0);
          ga[qg] = __builtin_amdgcn_mfma_f32_16x16x32_bf16(al, qf[qg][ks], ga[qg], 0, 0, 0);
        }
      }
#pragma unroll
      for (int qg = 0; qg < 2; ++qg) {
        float gate[8];
#pragma unroll
        for (int j = 0; j < 4; ++j) {
          float mine = ga[qg][j], oth = shfl16(mine);
          gate[j] = (fq & 1) ? oth : mine;
          gate[4 + j] = (fq & 1) ? mine : oth;
        }
        unsigned sl = 0;
#pragma unroll
        for (int r = 0; r < 3; ++r) {
          float best = -3.0e38f; int bi = 0;
#pragma unroll
          for (int j = 0; j < 8; ++j) {
            bool ok = (j < own) && !((sl >> j) & 1u) && (gate[j] > best);
            best = ok ? gate[j] : best; bi = ok ? j : bi;
          }
          sl |= 1u << bi;
        }
        sl = __shfl(sl, lane & 31);
        sel[qg] = sl;
      }
      unsigned u = sel[0] | sel[1];
#pragma unroll
      for (int o = 32; o >= 1; o >>= 1) u |= __shfl_xor(u, o);
      __syncthreads();
      if (tid == 0) *sU = 0u;
      __syncthreads();
      if (lane == 0) atomicOr(sU, u);
      __syncthreads();
      U = *sU;
    }
    ntile = n_own + 4 * __popc(U);
  }
  auto tile_k0 = [&](int i) -> int {
    if (KIND == 0) return (ntile - 1 - i) * 64;
    if (KIND == 2) return i * 64;
    if (i < n_own) return own_start + i * 64;
    int ii = i - n_own, nb = ii >> 2, blk = 0; unsigned u = U;
    for (int c = 0; c < nb; ++c) u &= u - 1;
    blk = __ffs(u) - 1;
    return blk * 256 + (ii & 3) * 64;
  };

  f32x4 o[2][4];
#pragma unroll
  for (int qg = 0; qg < 2; ++qg)
#pragma unroll
    for (int dt = 0; dt < 4; ++dt) o[qg][dt] = f32x4{0.f, 0.f, 0.f, 0.f};
  float carry[2] = {1.f, 1.f};
  float mrun[2] = {-1e30f, -1e30f}, lrun[2] = {0.f, 0.f};

  __syncthreads();
  tile_sstore(Ksb[0], Vsb[0], tid, rk, rv);
  if (ntile > 1) tile_gload(ts, tile_k0(1), tid, rk, rv);
  __syncthreads();
  auto step = [&](const int i, u32x4 (&lk)[2], u32x4 (&lv)[2], const u32x4 (&sk)[2], const u32x4 (&sv2)[2]) -> bool {
    const int k0 = tile_k0(i);
    const bf16_t* Ks = Ksb[i & 1]; const bf16_t* Vs = Vsb[i & 1];
    if (i + 2 < ntile) tile_gload(ts, tile_k0(i + 2), tid, lk, lv);
    bool skip = false, diag = false;
    if (KIND == 0) { skip = (k0 >= tmax); diag = (k0 + 63 >= tmin); }
    if (KIND == 1 && i < n_own) { skip = (k0 > tmax); diag = (k0 + 63 > tmin); }
    if (!skip) {
      bf16x8 pw[2][2];
      if (KIND == 0) {
#pragma unroll
        for (int qg = 0; qg < 2; ++qg) {
          const int t = tmin + qg * 16 + fr;
          f32x4 s[4];
          st_mfma(Ks, qf[qg], s, fr, fq);
          float om[16], be[16];
#pragma unroll
          for (int ii = 0; ii < 4; ++ii)
#pragma unroll
            for (int j = 0; j < 4; ++j) {
              const int e = ii * 4 + j;
              float z2 = fmaxf(s[ii][j] * C2, -100.f);
              float ex = __builtin_amdgcn_exp2f(-z2);
              float r = __builtin_amdgcn_rcpf(1.f + ex);
              be[e] = r; om[e] = ex * r;
            }
          if (diag) {
            asm volatile("" ::: "memory");
#pragma unroll
            for (int ii = 0; ii < 4; ++ii)
#pragma unroll
              for (int j = 0; j < 4; ++j) {
                const int e = ii * 4 + j;
                const int key = k0 + (ii >> 1) * 32 + 8 * fq + (ii & 1) * 4 + j;
                const bool act = key < t;
                be[e] = act ? be[e] : 0.f; om[e] = act ? om[e] : 1.f;
              }
          }
          float cp0 = om[0], cp1 = om[8];
#pragma unroll
          for (int e = 1; e < 8; ++e) { cp0 *= om[e]; cp1 *= om[8 + e]; }
          float a0 = shfl16(cp0), a1 = shfl16(cp1);
          float pr0 = cp0 * a0, pr1 = cp1 * a1;
          float b0 = shfl32(pr0), b1 = shfl32(pr1);
          float tot0 = pr0 * b0, tot1 = pr1 * b1;
          float sfx0 = (fq == 0) ? a0 * b0 : (fq == 1) ? b0 : (fq == 2) ? a0 : 1.f;
          float sfx1 = (fq == 0) ? a1 * b1 : (fq == 1) ? b1 : (fq == 2) ? a1 : 1.f;
          float w[16];
          float P = carry[qg] * sfx1;
#pragma unroll
          for (int e = 15; e >= 8; --e) { w[e] = be[e] * P; P *= om[e]; }
          P = carry[qg] * tot1 * sfx0;
#pragma unroll
          for (int e = 7; e >= 0; --e) { w[e] = be[e] * P; P *= om[e]; }
          carry[qg] *= tot1 * tot0;
          f32x4 w0 = {w[0], w[1], w[2], w[3]}, w1 = {w[4], w[5], w[6], w[7]};
          f32x4 w2 = {w[8], w[9], w[10], w[11]}, w3 = {w[12], w[13], w[14], w[15]};
          pw[qg][0] = pack8(w0, w1); pw[qg][1] = pack8(w2, w3);
        }
      } else {
#pragma unroll
        for (int qg = 0; qg < 2; ++qg) {
          const int t = tmin + qg * 16 + fr;
          f32x4 s[4];
          st_mfma(Ks, qf[qg], s, fr, fq);
          float sv[16];
          bool lanevalid = true;
          if (KIND == 1 && i >= n_own) lanevalid = (sel[qg] >> (k0 >> 8)) & 1u;
          float mx = -3.0e38f;
#pragma unroll
          for (int ii = 0; ii < 4; ++ii)
#pragma unroll
            for (int j = 0; j < 4; ++j) {
              const int e = ii * 4 + j;
              sv[e] = s[ii][j];
            }
          if (KIND == 1 && diag) {
            asm volatile("" ::: "memory");
#pragma unroll
            for (int ii = 0; ii < 4; ++ii)
#pragma unroll
              for (int j = 0; j < 4; ++j) {
                const int key = k0 + (ii >> 1) * 32 + 8 * fq + (ii & 1) * 4 + j;
                sv[ii * 4 + j] = (key <= t) ? sv[ii * 4 + j] : -3.0e38f;
              }
          }
#pragma unroll
          for (int e = 0; e < 16; ++e) mx = fmaxf(mx, sv[e]);
          mx = lanevalid ? mx : -3.0e38f;
          mx = fmaxf(mx, shfl16(mx));
          mx = fmaxf(mx, shfl32(mx));
          const float mnew = fmaxf(mrun[qg], mx * C2);
          const float alpha = __builtin_amdgcn_exp2f(mrun[qg] - mnew);
          mrun[qg] = mnew;
          const float c2e = lanevalid ? C2 : 0.f, nb = lanevalid ? -mnew : -1e30f;
          float ps = 0.f;
#pragma unroll
          for (int e = 0; e < 16; ++e) { sv[e] = __builtin_amdgcn_exp2f(__builtin_fmaf(sv[e], c2e, nb)); ps += sv[e]; }
          lrun[qg] = lrun[qg] * alpha + ps;
          if (__any(alpha != 1.f)) {
#pragma unroll
            for (int dt = 0; dt < 4; ++dt) o[qg][dt] *= alpha;
          }
          f32x4 w0 = {sv[0], sv[1], sv[2], sv[3]}, w1 = {sv[4], sv[5], sv[6], sv[7]};
          f32x4 w2 = {sv[8], sv[9], sv[10], sv[11]}, w3 = {sv[12], sv[13], sv[14], sv[15]};
          pw[qg][0] = pack8(w0, w1); pw[qg][1] = pack8(w2, w3);
        }
      }
      pv_mfma(Vs, pw, o, fr, fq);
    }
    if (i + 1 < ntile) tile_sstore(Ksb[(i + 1) & 1], Vsb[(i + 1) & 1], tid, sk, sv2);
    if (KIND == 0) {
      const int live = (carry[0] >= 1.17549435e-38f) || (carry[1] >= 1.17549435e-38f);
      if (!__syncthreads_or(live)) return true;
    } else {
      __syncthreads();
    }
    return false;
  };
#pragma unroll 1
  for (int i = 0; i < ntile; i += 2) {
    if (step(i, rk2, rv2, rk, rv)) break;
    if (i + 1 < ntile) { if (step(i + 1, rk, rv, rk2, rv2)) break; }
  }
#pragma unroll
  for (int qg = 0; qg < 2; ++qg) {
    const int t = tmin + qg * 16 + fr;
    float scale = 1.f;
    if (KIND != 0) {
      float l = lrun[qg];
      l += shfl16(l); l += shfl32(l);
      scale = 1.f / l;
    }
#pragma unroll
    for (int dt = 0; dt < 4; ++dt) {
      uint2 gu = *(const uint2*)(gbase + (size_t)t * INC + dt * 16 + fq * 4);
      float g0 = bflo(gu.x), g1 = bfhi(gu.x), g2 = bflo(gu.y), g3 = bfhi(gu.y);
      float r0 = o[qg][dt][0] * scale * g0 * __builtin_amdgcn_rcpf(1.f + __builtin_amdgcn_exp2f(-1.4426950408889634f * g0));
      float r1 = o[qg][dt][1] * scale * g1 * __builtin_amdgcn_rcpf(1.f + __builtin_amdgcn_exp2f(-1.4426950408889634f * g1));
      float r2 = o[qg][dt][2] * scale * g2 * __builtin_amdgcn_rcpf(1.f + __builtin_amdgcn_exp2f(-1.4426950408889634f * g2));
      float r3 = o[qg][dt][3] * scale * g3 * __builtin_amdgcn_rcpf(1.f + __builtin_amdgcn_exp2f(-1.4426950408889634f * g3));
      uint2 ou; ou.x = pack2(r0, r1); ou.y = pack2(r2, r3);
      *(uint2*)(obase + (size_t)t * 1024 + dt * 16 + fq * 4) = ou;
    }
  }
}

using f32x16 = __attribute__((ext_vector_type(16))) float;
template <int KIND>
DI void attn_item32(const Params& p, int layer, int item, char* smem, int g_tid, unsigned* qctr, int* s_item) {
  const int tid = g_tid, lane = tid & 63, wid = tid >> 6, q = lane & 31, hh = lane >> 5;
  bf16_t* Ksb[2]; bf16_t* Vsb[2];
  Ksb[0] = (bf16_t*)smem; Vsb[0] = Ksb[0] + 64 * AT_STR; Ksb[1] = Vsb[0] + 64 * AT_STR; Vsb[1] = Ksb[1] + 64 * AT_STR;
  unsigned* sU = (unsigned*)(smem + 4 * 64 * AT_STR * 2);
  int b, h, qt;
  const bf16_t *qbase, *gbase; bf16_t* obase; TileSrc ts;
  if (KIND == 0) {
    qt = 15 - (item & 15); int bh = item >> 4; h = bh % 6; b = bh / 6;
    const bf16_t* pb = p.proj + (size_t)(b * T) * INC;
    qbase = pb + C_SBQ + h * 64; gbase = pb + C_SBG + h * 64; ts.k = pb + C_SBK + h * 64; ts.kstride = INC;
    ts.v = pb + C_SBV + h * 64;
    obase = p.mixed + (size_t)(b * T) * 1024 + h * 64;
  } else if (KIND == 1) {
    qt = 15 - (item & 15); int bh = item >> 4; h = bh % 6; b = bh / 6;
    const bf16_t* pb = p.proj + (size_t)(b * T) * INC;
    qbase = pb + C_MBQ + h * 64; gbase = pb + C_MBG + h * 64; ts.k = pb + C_MBK + h * 64; ts.kstride = INC;
    ts.v = pb + C_MBV + h * 64;
    obase = p.mixed + (size_t)(b * T) * 1024 + 384 + h * 64;
  } else {
    qt = item & 15; int bh = item >> 4; h = bh & 3; b = bh >> 2;
    const bf16_t* pb = p.proj + (size_t)(b * T) * INC;
    qbase = pb + C_MQ + h * 64; gbase = pb + C_MG + h * 64;
    ts.k = p.mkv + (size_t)layer * NMEM * 512 + (size_t)(b * MEML) * 512 + h * 64; ts.kstride = 512;
    ts.v = ts.k + 256;
    obase = p.mixed + (size_t)(b * T) * 1024 + 768 + h * 64;
  }
  const int q0 = qt * 128;
  const int tmin = q0 + wid * 32, tmax = tmin + 31;
  const int t = tmin + q;
  bf16x8 qf[4];
#pragma unroll
  for (int ks = 0; ks < 4; ++ks) qf[ks] = *(const bf16x8*)(qbase + (size_t)t * INC + ks * 16 + hh * 8);
  uint2 gpre[2][4];
#pragma unroll
  for (int dt2 = 0; dt2 < 2; ++dt2)
#pragma unroll
    for (int g4 = 0; g4 < 4; ++g4) gpre[dt2][g4] = *(const uint2*)(gbase + (size_t)t * INC + dt2 * 32 + 8 * g4 + 4 * hh);
  const int own = q0 >> 8, own_start = own << 8;
  u32x4 rk[2], rv[2], rk2[2], rv2[2];
  tile_gload(ts, KIND == 0 ? ((q0 >> 6) + 1) * 64 : (KIND == 1 ? own_start : 0), tid, rk, rv);
  int ntile; unsigned U = 0; int n_own = 0; unsigned sel = 0u;
  if (KIND == 0) ntile = (q0 >> 6) + 2;
  else if (KIND == 2) ntile = 4;
  else {
    n_own = ((q0 - own_start) >> 6) + 2;
    if (own <= 3) { U = (1u << own) - 1u; sel = U; }
    else {
      f32x16 ga;
#pragma unroll
      for (int i = 0; i < 16; ++i) ga[i] = 0.f;
#pragma unroll
      for (int ks = 0; ks < 4; ++ks) {
        const float* kmp = p.kmean + (size_t)((layer * 8 + b) * 8 + (q & 7)) * 384 + h * 64 + ks * 16 + hh * 8;
        float4 k0v = *(const float4*)kmp, k1v = *(const float4*)(kmp + 4);
        float kmv[8] = {k0v.x, k0v.y, k0v.z, k0v.w, k1v.x, k1v.y, k1v.z, k1v.w};
        u32x4 hi, lo;
#pragma unroll
        for (int e = 0; e < 4; ++e) {
          float x0 = (q < 8) ? kmv[2 * e] : 0.f, x1 = (q < 8) ? kmv[2 * e + 1] : 0.f;
          bf16_t h0 = f2bf(x0), h1 = f2bf(x1);
          hi[e] = (unsigned)h0 | ((unsigned)h1 << 16);
          lo[e] = pack2(x0 - bf2f(h0), x1 - bf2f(h1));
        }
        ga = __builtin_amdgcn_mfma_f32_32x32x16_bf16(__builtin_bit_cast(bf16x8, hi), qf[ks], ga, 0, 0, 0);
        ga = __builtin_amdgcn_mfma_f32_32x32x16_bf16(__builtin_bit_cast(bf16x8, lo), qf[ks], ga, 0, 0, 0);
      }
      float gate[8];
#pragma unroll
      for (int j = 0; j < 4; ++j) {
        const float mine = ga[j], oth = shfl32(mine);
        gate[j] = hh ? oth : mine;
        gate[4 + j] = hh ? mine : oth;
      }
      unsigned sl = 0;
#pragma unroll
      for (int r = 0; r < 3; ++r) {
        float best = -3.0e38f; int bi = 0;
#pragma unroll
        for (int j = 0; j < 8; ++j) {
          bool ok = (j < own) && !((sl >> j) & 1u) && (gate[j] > best);
          best = ok ? gate[j] : best; bi = ok ? j : bi;
        }
        sl |= 1u << bi;
      }
      sel = sl;
      unsigned u = sel;
#pragma unroll
      for (int o = 32; o >= 1; o >>= 1) u |= __shfl_xor(u, o);
      __syncthreads();
      if (tid == 0) *sU = 0u;
      __syncthreads();
      if (lane == 0) atomicOr(sU, u);
      __syncthreads();
      U = *sU;
    }
    ntile = n_own + 4 * __popc(U);
  }
  auto tile_k0 = [&](int i) -> int {
    if (KIND == 0) return (ntile - 1 - i) * 64;
    if (KIND == 2) return i * 64;
    if (i < n_own) return own_start + i * 64;
    int ii = i - n_own, nb = ii >> 2, blk = 0; unsigned u = U;
    for (int c = 0; c < nb; ++c) u &= u - 1;
    blk = __ffs(u) - 1;
    return blk * 256 + (ii & 3) * 64;
  };
  f32x16 o[2];
#pragma unroll
  for (int dt2 = 0; dt2 < 2; ++dt2)
#pragma unroll
    for (int i = 0; i < 16; ++i) o[dt2][i] = 0.f;
  float mrun = -1e30f, lrun = 0.f;
  float carry = 1.f;
  const int qa = (q >> 2) & 1, qb = q >> 3, qc = q & 3;
  const int krow0 = (qb & 1) * 16 + (2 * qa + (qb >> 1)) * 4 + qc;
  const int vq4 = (lane & 15) >> 2, vp4 = lane & 3, vblk = (lane >> 4) & 1;

  __syncthreads();
  tile_sstore(Ksb[0], Vsb[0], tid, rk, rv);
  if (ntile > 1) tile_gload(ts, tile_k0(1), tid, rk, rv);
  __syncthreads();
  auto step = [&](const int i, u32x4 (&lk)[2], u32x4 (&lv)[2], const u32x4 (&sk)[2], const u32x4 (&sv2)[2]) -> bool {
    const int k0 = tile_k0(i);
    const bf16_t* Ks = Ksb[i & 1]; const bf16_t* Vs = Vsb[i & 1];
    if (i + 2 < ntile) tile_gload(ts, tile_k0(i + 2), tid, lk, lv);
    bool skip = false, diag = false;
    if (KIND == 0) { skip = (k0 >= tmax); diag = (k0 + 63 >= tmin); }
    if (KIND == 1 && i < n_own) { skip = (k0 > tmax); diag = (k0 + 63 > tmin); }
    if (!skip) {
      f32x16 s[2];
      float om[2][16];
#pragma unroll
      for (int kt2 = 0; kt2 < 2; ++kt2) {
        f32x16 z;
#pragma unroll
        for (int e = 0; e < 16; ++e) z[e] = 0.f;
#pragma unroll
        for (int ks = 0; ks < 4; ++ks) {
          const bf16x8 a = *(const bf16x8*)(Ks + (kt2 * 32 + krow0) * AT_STR + ks * 16 + hh * 8);
          z = __builtin_amdgcn_mfma_f32_32x32x16_bf16(a, qf[ks], z, 0, 0, 0);
        }
        s[kt2] = z;
      }
      if (KIND == 0) {
#pragma unroll
        for (int kt2 = 0; kt2 < 2; ++kt2)
#pragma unroll
          for (int e = 0; e < 16; ++e) {
            const float z2 = fmaxf(s[kt2][e] * C2, -100.f);
            const float ex = __builtin_amdgcn_exp2f(-z2);
            const float r = __builtin_amdgcn_rcpf(1.f + ex);
            s[kt2][e] = r; om[kt2][e] = ex * r;
          }
        if (diag) {
          asm volatile("" ::: "memory");
#pragma unroll
          for (int kt2 = 0; kt2 < 2; ++kt2)
#pragma unroll
            for (int e = 0; e < 16; ++e) {
              const bool act = (k0 + kt2 * 32 + 16 * hh + e) < t;
              s[kt2][e] = act ? s[kt2][e] : 0.f; om[kt2][e] = act ? om[kt2][e] : 1.f;
            }
        }
        float cp0 = om[0][0], cp1 = om[1][0];
#pragma unroll
        for (int e = 1; e < 16; ++e) { cp0 *= om[0][e]; cp1 *= om[1][e]; }
        const float oc0 = shfl32(cp0), oc1 = shfl32(cp1);
        const float tot0 = cp0 * oc0, tot1 = cp1 * oc1;
        float P = carry * (hh ? 1.f : oc1);
#pragma unroll
        for (int e = 15; e >= 0; --e) { const float w = s[1][e] * P; P *= om[1][e]; s[1][e] = w; }
        P = carry * tot1 * (hh ? 1.f : oc0);
#pragma unroll
        for (int e = 15; e >= 0; --e) { const float w = s[0][e] * P; P *= om[0][e]; s[0][e] = w; }
        carry *= tot0 * tot1;
      } else {
      bool lanevalid = true;
      if (KIND == 1 && i >= n_own) lanevalid = (sel >> (k0 >> 8)) & 1u;
      if (KIND == 1 && diag) {
        asm volatile("" ::: "memory");
#pragma unroll
        for (int kt2 = 0; kt2 < 2; ++kt2)
#pragma unroll
          for (int e = 0; e < 16; ++e) {
            const int key = k0 + kt2 * 32 + 16 * hh + e;
            s[kt2][e] = (key <= t) ? s[kt2][e] : -3.0e38f;
          }
      }
      float mx = -3.0e38f;
#pragma unroll
      for (int kt2 = 0; kt2 < 2; ++kt2)
#pragma unroll
        for (int e = 0; e < 16; ++e) mx = fmaxf(mx, s[kt2][e]);
      mx = lanevalid ? mx : -3.0e38f;
      mx = fmaxf(mx, shfl32(mx));
      const float mnew = fmaxf(mrun, mx * C2);
      const float alpha = __builtin_amdgcn_exp2f(mrun - mnew);
      mrun = mnew;
      const float c2e = lanevalid ? C2 : 0.f, nb = lanevalid ? -mnew : -1e30f;
      float ps = 0.f;
#pragma unroll
      for (int kt2 = 0; kt2 < 2; ++kt2)
#pragma unroll
        for (int e = 0; e < 16; ++e) { s[kt2][e] = __builtin_amdgcn_exp2f(__builtin_fmaf(s[kt2][e], c2e, nb)); ps += s[kt2][e]; }
      lrun = lrun * alpha + ps;
      if (__any(alpha != 1.f)) {
#pragma unroll
        for (int dt2 = 0; dt2 < 2; ++dt2) o[dt2] *= alpha;
      }
      }
      bf16x8 pw[2][2];
#pragma unroll
      for (int kt2 = 0; kt2 < 2; ++kt2)
#pragma unroll
        for (int s2 = 0; s2 < 2; ++s2) {
          f32x4 w0 = {s[kt2][8 * s2 + 0], s[kt2][8 * s2 + 1], s[kt2][8 * s2 + 2], s[kt2][8 * s2 + 3]};
          f32x4 w1 = {s[kt2][8 * s2 + 4], s[kt2][8 * s2 + 5], s[kt2][8 * s2 + 6], s[kt2][8 * s2 + 7]};
          pw[kt2][s2] = pack8(w0, w1);
        }
#pragma unroll
      for (int dt2 = 0; dt2 < 2; ++dt2)
#pragma unroll
        for (int kt2 = 0; kt2 < 2; ++kt2)
#pragma unroll
          for (int s2 = 0; s2 < 2; ++s2) {
            const bf16_t* vp = Vs + (kt2 * 32 + 16 * hh + 8 * s2 + vq4) * AT_STR + dt2 * 32 + vblk * 16 + 4 * vp4;
            s16x4_t lo = __builtin_amdgcn_ds_read_tr16_b64_v4i16((__attribute__((address_space(3))) s16x4_t*)(vp));
            s16x4_t hi = __builtin_amdgcn_ds_read_tr16_b64_v4i16((__attribute__((address_space(3))) s16x4_t*)(vp + 4 * AT_STR));
            bf16x8 a = __builtin_shufflevector(lo, hi, 0, 1, 2, 3, 4, 5, 6, 7);
            o[dt2] = __builtin_amdgcn_mfma_f32_32x32x16_bf16(a, pw[kt2][s2], o[dt2], 0, 0, 0);
          }
    }
    if (i + 1 < ntile) tile_sstore(Ksb[(i + 1) & 1], Vsb[(i + 1) & 1], tid, sk, sv2);
    if (KIND == 0) {
      if (!__syncthreads_or(carry >= 1.17549435e-38f)) return true;
    } else {
      __syncthreads();
    }
    return false;
  };
#pragma unroll 1
  for (int i = 0; i < ntile; i += 2) {
    if (step(i, rk2, rv2, rk, rv)) break;
    if (i + 1 < ntile) { if (step(i + 1, rk, rv, rk2, rv2)) break; }
  }
  unsigned nxt_item = 0u;
  if (tid == 0) nxt_item = gridDim.x + atomicAdd(qctr, 1u);
  {
    float l = lrun;
    l += shfl32(l);
    const float scale = (KIND == 0) ? 1.f : __builtin_amdgcn_rcpf(l);
#pragma unroll
    for (int dt2 = 0; dt2 < 2; ++dt2)
#pragma unroll
      for (int g4 = 0; g4 < 4; ++g4) {
        const int d0 = dt2 * 32 + 8 * g4 + 4 * hh;
        const uint2 gu = gpre[dt2][g4];
        const float gg[4] = {bflo(gu.x), bfhi(gu.x), bflo(gu.y), bfhi(gu.y)};
        float r[4];
#pragma unroll
        for (int j = 0; j < 4; ++j)
          r[j] = o[dt2][g4 * 4 + j] * scale * gg[j] * __builtin_amdgcn_rcpf(1.f + __builtin_amdgcn_exp2f(-1.4426950408889634f * gg[j]));
        uint2 ou; ou.x = pack2(r[0], r[1]); ou.y = pack2(r[2], r[3]);
        *(uint2*)(obase + (size_t)t * 1024 + d0) = ou;
      }
  }
  if (tid == 0) *s_item = (int)nxt_item;
}

DI void phase_attn(const Params& p, int layer, char* smem, int g_tid, int g_bid) {
  int* s_item = (int*)(smem + 4 * 64 * AT_STR * 2 + 16);
  unsigned* qctr = p.bar + 3456 + layer * 16;
  __syncthreads();
  if (g_tid == 0) *s_item = g_bid;
  for (;;) {
    __syncthreads();
    const int it = *s_item;
    if (it >= 2048) break;
    if (it < 768) { int qrank = it / 48, bh = it % 48; attn_item32<1>(p, layer, bh * 16 + qrank, smem, g_tid, qctr, s_item); }
    else if (it < 1536) { int u = it - 768; int qrank = u / 48, bh = u % 48; attn_item32<0>(p, layer, bh * 16 + qrank, smem, g_tid, qctr, s_item); }
    else attn_item32<2>(p, layer, it - 1536, smem, g_tid, qctr, s_item);
  }
}

DI void phase_final(const Params& p, int g_tid, int g_bid) {
  const int lane = g_tid & 63, wid = g_tid >> 6;
  const int stride = gridDim.x * 4;
  float4 g[2][2];
#pragma unroll
  for (int i = 0; i < 2; ++i) { g[i][0] = *(const float4*)(p.final_g + i * 512 + lane * 8); g[i][1] = *(const float4*)(p.final_g + i * 512 + lane * 8 + 4); }
  for (int r0 = g_bid * 4 + wid; r0 < NTOK; r0 += 4 * stride) {
    uint4 v[4][2]; float ssv[4];
#pragma unroll
    for (int u = 0; u < 4; ++u) {
      const int r = r0 + u * stride;
      if (r < NTOK) {
        ssv[u] = p.ss[2 * NTOK + r];
#pragma unroll
        for (int i = 0; i < 2; ++i) v[u][i] = *(const uint4*)(p.xb + (size_t)r * 1024 + i * 512 + lane * 8);
      }
    }
#pragma unroll
    for (int u = 0; u < 4; ++u) {
      const int r = r0 + u * stride;
      if (r < NTOK) {
        const float rs = rsqrtf(ssv[u] * (1.f / 1024.f) + 1e-6f);
#pragma unroll
        for (int i = 0; i < 2; ++i) {
          const uint4 w = v[u][i];
          float4 o0, o1;
          o0.x = bflo(w.x) * rs * g[i][0].x; o0.y = bfhi(w.x) * rs * g[i][0].y; o0.z = bflo(w.y) * rs * g[i][0].z; o0.w = bfhi(w.y) * rs * g[i][0].w;
          o1.x = bflo(w.z) * rs * g[i][1].x; o1.y = bfhi(w.z) * rs * g[i][1].y; o1.z = bflo(w.w) * rs * g[i][1].z; o1.w = bfhi(w.w) * rs * g[i][1].w;
          *(float4*)(p.out + (size_t)r * 1024 + i * 512 + lane * 8) = o0;
          *(float4*)(p.out + (size_t)r * 1024 + i * 512 + lane * 8 + 4) = o1;
        }
      }
    }
  }
}

#define XB_TMO      128
#define XB_XCNT(j)  (256  + 64 * (j))
#define XB_XSUB(j)  (1280 + 64 * (j))
#define XB_XGEN(j)  (2304 + 64 * (j))
#define XB_TOP      3328
#define XB_TOPGEN   3392
#define XCD_BAR_WORDS 3456
#define XB_SPIN_CAP (1u << 18)
#define LAS __attribute__((address_space(3)))
DI unsigned xb_ld(unsigned* p) { return __hip_atomic_load(p, __ATOMIC_RELAXED, __HIP_MEMORY_SCOPE_AGENT); }
DI unsigned xb_add(unsigned* p, unsigned v) { return __hip_atomic_fetch_add(p, v, __ATOMIC_RELAXED, __HIP_MEMORY_SCOPE_AGENT); }
DI unsigned xb_xcc_id() { return (unsigned)__builtin_amdgcn_s_getreg((3 << 11) | 20) & 0xFu; }
#define XB_SPIN(cond, bar) do { unsigned _sp = 0; while (cond) { __builtin_amdgcn_s_sleep(1); \
    if ((++_sp & 255u) == 0u) { if (xb_ld(&(bar)[XB_TMO])) break; if (_sp > XB_SPIN_CAP) { atomicAdd(&(bar)[XB_TMO], 1u); break; } } } } while (0)
struct XcdBarrier { unsigned* bar; unsigned x; volatile LAS unsigned* st; };
DI XcdBarrier xcd_barrier_post(unsigned* bar, volatile LAS unsigned* st) {
  XcdBarrier b; b.bar = bar; b.x = xb_xcc_id(); b.st = st;
  if (threadIdx.x == 0) (void)xb_add(&bar[XB_XCNT(b.x)], 1u);
  return b;
}
DI void xcd_barrier_complete(unsigned* bar, unsigned x, unsigned& nloc, unsigned& nx) {
  const unsigned G = gridDim.x * gridDim.y * gridDim.z;
  unsigned sum, cnt, mine, sp = 0u;
  for (;;) {
    sum = 0u; cnt = 0u; mine = 0u;
#pragma unroll
    for (unsigned j = 0; j < 16; ++j) { const unsigned c = xb_ld(&bar[XB_XCNT(j)]); sum += c; cnt += (c > 0u) ? 1u : 0u; mine = (j == x) ? c : mine; }
    if (sum == G) break;
    __builtin_amdgcn_s_sleep(1);
    if ((++sp & 255u) == 0u) { if (xb_ld(&bar[XB_TMO])) break; if (sp > XB_SPIN_CAP) { atomicAdd(&bar[XB_TMO], 1u); break; } }
  }
  nloc = mine > 0u ? mine : 1u; nx = cnt > 0u ? cnt : 1u;
}
DI void xcd_barrier(const XcdBarrier& b) {
  asm volatile("s_waitcnt vmcnt(0)" ::: "memory");
  __syncthreads();
  if (threadIdx.x == 0) {
    unsigned* bar = b.bar;
    __builtin_amdgcn_s_waitcnt(0);
    unsigned nloc = b.st[0], nx = b.st[1];
    if (nloc == 0u) { xcd_barrier_complete(bar, b.x, nloc, nx); b.st[0] = nloc; b.st[1] = nx; }
    const unsigned old = xb_add(&bar[XB_XSUB(b.x)], 1u);
    const unsigned gen = old / nloc;
    if (old + 1u == (gen + 1u) * nloc) {
      __builtin_amdgcn_fence(__ATOMIC_RELEASE, "agent");
      asm volatile("s_waitcnt vmcnt(0)" ::: "memory");
      const unsigned og = xb_add(&bar[XB_TOP], 1u);
      const unsigned tg = og / nx;
      if (og + 1u == (tg + 1u) * nx) xb_add(&bar[XB_TOPGEN], 1u);
      else XB_SPIN(xb_ld(&bar[XB_TOPGEN]) == tg, bar);
      __builtin_amdgcn_fence(__ATOMIC_ACQUIRE, "agent");
      xb_add(&bar[XB_XGEN(b.x)], 1u);
      asm volatile("s_waitcnt vmcnt(0)" ::: "memory");
    } else {
      XB_SPIN(xb_ld(&bar[XB_XGEN(b.x)]) == gen, bar);
      __builtin_amdgcn_fence(__ATOMIC_ACQUIRE, "agent");
      asm volatile("s_waitcnt vmcnt(0)" ::: "memory");
    }
  }
  __syncthreads();
}

constexpr int NPHASE = 8;
#define PHASE_BEGIN(n) if (ph_lo <= (n) && (n) < ph_hi) { int g_tid = threadIdx.x, g_bid = blockIdx.x; asm volatile("" : "+v"(g_tid)); asm volatile("" : "+s"(g_bid));
#define PHASE_END(n) if ((n) + 1 < ph_hi) xcd_barrier(xb); }
__global__ void __launch_bounds__(256, 2) mega(Params p, int ph_lo, int ph_hi) {
  __shared__ __attribute__((aligned(16))) char smem[3 * G_STAGE + 64];
  __shared__ uint4 xb_words;
  cg::grid_group grid = cg::this_grid();
  if (ph_hi < 0) grid.sync();
  if (threadIdx.x == 0) xb_words = make_uint4(0u, 0u, 0u, 0u);
  __syncthreads();
  XcdBarrier xb = xcd_barrier_post(p.bar, (volatile LAS unsigned*)&xb_words);
  PHASE_BEGIN(0) phase_prepass(p, smem, g_tid, g_bid); PHASE_END(0)
  PHASE_BEGIN(1)
    {
      const int xcd = g_bid & 7, loc = g_bid >> 3, nloc = gridDim.x >> 3;
      const int nr1 = (272 + nloc - 1) / nloc; const bool stag = loc >= (nloc >> 1);
      for (int r = 0; r < nr1; ++r) {
        const int rr = stag ? (r + 3) % nr1 : r;
        const int j = loc + rr * nloc;
        if (j >= 272) continue;
        if (j < 192) gemm_tile<0, 8>(p, 0, xcd * 8 + (j & 7), j >> 3, smem, g_tid);
        else if (j < 256) { int jj = 192 + ((j - 192) >> 1), hf = j & 1; gemm_tile<0, 4>(p, 0, (xcd * 8 + (jj & 7)) * 2 + hf, jj >> 3, smem, g_tid); }
        else { int u = xcd * 16 + (j - 256); int layer = u >> 6, r = u & 63; gemm_tile<1, 4>(p, layer, r >> 2, r & 3, smem, g_tid); }
      }
    }
  PHASE_END(1)
  PHASE_BEGIN(2) phase_attn(p, 0, smem, g_tid, g_bid); PHASE_END(2)
  PHASE_BEGIN(3)
    {
      const int xcd = g_bid & 7, loc = g_bid >> 3, nloc = gridDim.x >> 3;
      for (int j = loc; j < 64; j += nloc) gemm_tile<2, 8>(p, 0, xcd * 8 + (j & 7), j >> 3, smem, g_tid);
    }
  PHASE_END(3)
  PHASE_BEGIN(4)
    {
      const int xcd = g_bid & 7, loc = g_bid >> 3, nloc = gridDim.x >> 3;
      const int nr4 = (256 + nloc - 1) / nloc; const bool stag = loc >= (nloc >> 1);
      for (int r = 0; r < nr4; ++r) {
        const int rr = stag ? (r + nr4 - 1) % nr4 : r;
        const int j = loc + rr * nloc;
        if (j >= 256) continue;
        if (j < 192) gemm_tile<0, 8>(p, 1, xcd * 8 + (j & 7), j >> 3, smem, g_tid);
        else { int jj = 192 + ((j - 192) >> 1), hf = j & 1; gemm_tile<0, 4>(p, 1, (xcd * 8 + (jj & 7)) * 2 + hf, jj >> 3, smem, g_tid); }
      }
    }
  PHASE_END(4)
  PHASE_BEGIN(5) phase_attn(p, 1, smem, g_tid, g_bid); PHASE_END(5)
  PHASE_BEGIN(6)
    {
      const int xcd = g_bid & 7, loc = g_bid >> 3, nloc = gridDim.x >> 3;
      for (int j = loc; j < 64; j += nloc) gemm_tile<2, 8>(p, 1, xcd * 8 + (j & 7), j >> 3, smem, g_tid);
    }
  PHASE_END(6)
  PHASE_BEGIN(7) phase_final(p, g_tid, g_bid); PHASE_END(7)
}

extern "C" void kernel_launch(void* const* d_in, const int* in_sizes, int n_in, void* d_out, int out_size, void* d_ws, size_t ws_size,
                              hipStream_t stream) {
  Params p{};
  p.x = (const float*)d_in[0]; p.mem = (const float*)d_in[1]; p.norm_g = (const float*)d_in[2]; p.w_in = (const float*)d_in[3];
  p.mem_norm_g = (const float*)d_in[4]; p.w_mem_kv = (const float*)d_in[5]; p.w_out = (const float*)d_in[6];
  p.final_g = (const float*)d_in[7];
  p.out = (float*)d_out;
  char* ws = (char*)d_ws;
  p.xb = (bf16_t*)(ws + 0);
  p.proj = (bf16_t*)(ws + 33554432ull);
  p.mixed = (bf16_t*)(ws + 150994944ull);
  p.wTin = (bf16_t*)(ws + 184549376ull);
  p.wTkv = (bf16_t*)(ws + 199229440ull);
  p.wTout = (bf16_t*)(ws + 201326592ull);
  p.memb = (bf16_t*)(ws + 205520896ull);
  p.mkv = (bf16_t*)(ws + 209715200ull);
  p.ss = (float*)(ws + 213909504ull);
  p.memss = (float*)(ws + 214106112ull);
  p.kmean = (float*)(ws + 214114304ull);
  p.costab = (float*)(ws + 214310912ull);
  p.sintab = (float*)(ws + 214376448ull);
  p.sbvT = (bf16_t*)(ws + 214441984ull);
  p.mbvT = (bf16_t*)(ws + 227024896ull);
  p.mvT = (bf16_t*)(ws + 239607808ull);
  p.bar = (unsigned*)(ws + 241704960ull);

  static int grid_blocks = 0;
  if (!grid_blocks) {
    int dev = 0, cus = 0, per_cu = 0;
    (void)hipGetDevice(&dev);
    (void)hipDeviceGetAttribute(&cus, hipDeviceAttributeMultiprocessorCount, dev);
    (void)hipOccupancyMaxActiveBlocksPerMultiprocessor(&per_cu, mega, 256, 0);
    if (per_cu > 2) per_cu = 2;
    if (per_cu < 1) per_cu = 1;
    grid_blocks = cus * per_cu;
  }
#if MULTI_LAUNCH
  for (int ph = 0; ph < NPHASE; ++ph) {
    if (NAIVE_ATTN && (ph == 2 || ph == 5)) {
      int layer = ph == 2 ? 0 : 1;
      hipLaunchKernelGGL(attn_naive_sb, dim3(384), dim3(256), 0, stream, p, layer);
      hipLaunchKernelGGL(attn_naive_moba, dim3(384), dim3(256), 0, stream, p, layer);
      hipLaunchKernelGGL(attn_naive_mem, dim3(256), dim3(256), 0, stream, p, layer);
    } else {
      hipLaunchKernelGGL(mega, dim3(grid_blocks), dim3(256), 0, stream, p, ph, ph + 1);
    }
  }
#else
  int lo = 0, hi = NPHASE;
  (void)hipMemsetAsync(p.bar, 0, (XCD_BAR_WORDS + 64) * sizeof(unsigned), stream);
  void* args[] = {&p, &lo, &hi};
  hipError_t e = hipLaunchCooperativeKernel((void*)mega, dim3(grid_blocks), dim3(256), args, 0, stream);
  if (e != hipSuccess) fprintf(stderr, "cooperative launch failed: %s (grid %d)\n", hipGetErrorString(e), grid_blocks);
#endif
}
```

```cpp
#include <hip/hip_runtime.h>
#include <hip/hip_cooperative_groups.h>
#include <stdint.h>
#include <cstdio>
namespace cg = cooperative_groups;

#ifndef MULTI_LAUNCH
#define MULTI_LAUNCH 0
#endif
#ifndef NAIVE_ATTN
#define NAIVE_ATTN 0
#endif

typedef unsigned short bf16_t;
using bf16x8 = __attribute__((ext_vector_type(8))) short;
using f32x4 = __attribute__((ext_vector_type(4))) float;
using u32x4 = __attribute__((ext_vector_type(4))) unsigned;
#define DI __device__ __forceinline__

constexpr int NB = 8, T = 2048, D = 1024, NTOK = NB * T, INC = 3584, MEML = 256, NMEM = NB * MEML;
constexpr int C_SBQ = 0, C_SBK = 384, C_SBV = 768, C_SBG = 1152, C_MBQ = 1536, C_MBK = 1920, C_MBV = 2304, C_MBG = 2688,
              C_MQ = 3072, C_MG = 3328;

struct Params {
  const float* x; const float* mem; const float* norm_g; const float* w_in; const float* mem_norm_g;
  const float* w_mem_kv; const float* w_out; const float* final_g;
  float* out;
  bf16_t* xb; bf16_t* proj; bf16_t* mixed; bf16_t* wTin; bf16_t* wTkv; bf16_t* wTout; bf16_t* memb; bf16_t* mkv;
  float* ss; float* memss; float* kmean; float* costab; float* sintab;
  bf16_t* sbvT; bf16_t* mbvT; bf16_t* mvT;
  unsigned* bar;
};

DI bf16_t f2bf(float x) { unsigned u = __float_as_uint(x); u += 0x7fffu + ((u >> 16) & 1u); return (bf16_t)(u >> 16); }
DI float bf2f(bf16_t b) { return __uint_as_float(((unsigned)b) << 16); }
DI float bflo(unsigned u) { return __uint_as_float(u << 16); }
DI float bfhi(unsigned u) { return __uint_as_float(u & 0xffff0000u); }
typedef float f32x2_t __attribute__((ext_vector_type(2)));
typedef __bf16 bf16x2_t __attribute__((ext_vector_type(2)));
DI unsigned pack2(float a, float b) { f32x2_t v = {a, b}; return __builtin_bit_cast(unsigned, __builtin_convertvector(v, bf16x2_t)); }
DI float4 ld_nt4(const float* ptr) { f32x4 t = __builtin_nontemporal_load((const f32x4*)ptr); return float4{t[0], t[1], t[2], t[3]}; }
DI float shfl16(float x) {
  const unsigned u = __float_as_uint(x);
  auto r = __builtin_amdgcn_permlane16_swap(u, u, false, false);
  return __uint_as_float((r[0] == u) ? r[1] : r[0]);
}
DI float shfl32(float x) {
  const unsigned u = __float_as_uint(x);
  auto r = __builtin_amdgcn_permlane32_swap(u, u, false, false);
  return __uint_as_float((r[0] == u) ? r[1] : r[0]);
}
DI float wave_sum(float v) {
#pragma unroll
  for (int o = 32; o >= 1; o >>= 1) v += __shfl_xor(v, o);
  return v;
}

DI void transpose_tile(const float* __restrict__ src, const float* __restrict__ g, bf16_t* __restrict__ dst, int N, int kt, int nt,
                       float* tile, int g_tid) {
  const int tid = g_tid;
  __syncthreads();
#pragma unroll
  for (int pss = 0; pss < 4; ++pss) {
    int kr = pss * 16 + (tid >> 4), nc = (tid & 15) * 4;
    int k = kt * 64 + kr;
    float4 v = ld_nt4(src + (size_t)k * N + nt * 64 + nc);
    float gs = g ? g[k] : 1.f;
    tile[kr * 65 + nc + 0] = v.x * gs; tile[kr * 65 + nc + 1] = v.y * gs;
    tile[kr * 65 + nc + 2] = v.z * gs; tile[kr * 65 + nc + 3] = v.w * gs;
  }
  __syncthreads();
#pragma unroll
  for (int pss = 0; pss < 2; ++pss) {
    int nr = pss * 32 + (tid >> 3), kc = (tid & 7) * 8;
    uint4 o;
    o.x = pack2(tile[(kc + 0) * 65 + nr], tile[(kc + 1) * 65 + nr]);
    o.y = pack2(tile[(kc + 2) * 65 + nr], tile[(kc + 3) * 65 + nr]);
    o.z = pack2(tile[(kc + 4) * 65 + nr], tile[(kc + 5) * 65 + nr]);
    o.w = pack2(tile[(kc + 6) * 65 + nr], tile[(kc + 7) * 65 + nr]);
    *(uint4*)(dst + (size_t)(nt * 64 + nr) * 1024 + kt * 64 + kc) = o;
  }
}

DI void row_convert(const float* __restrict__ src, bf16_t* __restrict__ dst, float* __restrict__ ssout, int row, int lane) {
  const float* r = src + (size_t)row * 1024;
  float s = 0.f;
#pragma unroll
  for (int i = 0; i < 2; ++i) {
    int c = i * 512 + lane * 8;
    float4 a = *(const float4*)(r + c), b = *(const float4*)(r + c + 4);
    s += a.x * a.x + a.y * a.y + a.z * a.z + a.w * a.w + b.x * b.x + b.y * b.y + b.z * b.z + b.w * b.w;
    uint4 o; o.x = pack2(a.x, a.y); o.y = pack2(a.z, a.w); o.z = pack2(b.x, b.y); o.w = pack2(b.z, b.w);
    *(uint4*)(dst + (size_t)row * 1024 + c) = o;
  }
  s = wave_sum(s);
  if (lane == 0) ssout[row] = s;
}

DI void phase_prepass(const Params& p, char* smem, int g_tid, int g_bid) {
  const int tid = g_tid, lane = tid & 63, wid = tid >> 6;
  const int gtid = g_bid * 256 + tid, gth = gridDim.x * 256;
  for (int i = gtid; i < 2 * 8 * 8 * 384; i += gth) p.kmean[i] = 0.f;
  for (int i = gtid; i < 2 * NTOK; i += gth) p.ss[NTOK + i] = 0.f;
  for (int i = gtid; i < T * 8; i += gth) {
    int pos = i >> 3, f = i & 7;
    const float invf[8] = {1.000000000e+00f, 1.939227447e-01f, 3.760603093e-02f, 7.292664737e-03f, 1.414213562e-03f, 2.742481757e-04f, 5.318295897e-05f, 1.031338538e-05f};
    float inv = invf[0];
#pragma unroll
    for (int q = 1; q < 8; ++q) inv = (f == q) ? invf[q] : inv;
    float ang = (float)pos * inv;
    p.costab[i] = cosf(ang); p.sintab[i] = sinf(ang);
  }
  const int NT_IN = 16 * 56, NT_KV = 16 * 8, NT_OUT = 16 * 16;
  const int per_layer = NT_IN + NT_KV + NT_OUT;
  for (int job = g_bid; job < 2 * per_layer; job += gridDim.x) {
    int layer = job / per_layer, j = job % per_layer;
    if (j < NT_IN) {
      transpose_tile(p.w_in + (size_t)layer * 1024 * INC, p.norm_g + layer * 1024, p.wTin + (size_t)layer * INC * 1024, INC, j / 56, j % 56,
                     (float*)smem, g_tid);
    } else if (j < NT_IN + NT_KV) {
      j -= NT_IN;
      transpose_tile(p.w_mem_kv + (size_t)layer * 1024 * 512, p.mem_norm_g + layer * 1024, p.wTkv + (size_t)layer * 512 * 1024, 512, j / 8,
                     j % 8, (float*)smem, g_tid);
    } else {
      j -= NT_IN + NT_KV;
      transpose_tile(p.w_out + (size_t)layer * 1024 * 1024, nullptr, p.wTout + (size_t)layer * 1024 * 1024, 1024, j / 16, j % 16,
                     (float*)smem, g_tid);
    }
  }
  {
    const int stride = gridDim.x * 4;
    for (int r0 = g_bid * 4 + wid; r0 < NTOK + NMEM; r0 += 3 * stride) {
      float4 va[3][4];
#pragma unroll
      for (int u = 0; u < 3; ++u) {
        const int r = r0 + u * stride;
        if (r < NTOK + NMEM) {
          const float* rp = (r < NTOK) ? p.x + (size_t)r * 1024 : p.mem + (size_t)(r - NTOK) * 1024;
#pragma unroll
          for (int i = 0; i < 2; ++i) { va[u][2 * i] = ld_nt4(rp + i * 512 + lane * 8); va[u][2 * i + 1] = ld_nt4(rp + i * 512 + lane * 8 + 4); }
        }
      }
#pragma unroll
      for (int u = 0; u < 3; ++u) {
        const int r = r0 + u * stride;
        if (r < NTOK + NMEM) {
          bf16_t* dp = (r < NTOK) ? p.xb + (size_t)r * 1024 : p.memb + (size_t)(r - NTOK) * 1024;
          float sacc = 0.f;
#pragma unroll
          for (int i = 0; i < 2; ++i) {
            const float4 a = va[u][2 * i], b = va[u][2 * i + 1];
            sacc += a.x * a.x + a.y * a.y + a.z * a.z + a.w * a.w + b.x * b.x + b.y * b.y + b.z * b.z + b.w * b.w;
            uint4 o; o.x = pack2(a.x, a.y); o.y = pack2(a.z, a.w); o.z = pack2(b.x, b.y); o.w = pack2(b.z, b.w);
            *(uint4*)(dp + i * 512 + lane * 8) = o;
          }
          sacc = wave_sum(sacc);
          if (lane == 0) { if (r < NTOK) p.ss[r] = sacc; else p.memss[r - NTOK] = sacc; }
        }
      }
    }
  }
}

constexpr int LDS_STR = 72;
constexpr int G_STAGE = (256 + 128) * 64;

template <int MODE, int MT>
DI void gemm_tile(const Params& p, int layer, int mt, int nt, char* smem, int g_tid) {
  const int tid = g_tid, lane = tid & 63, wid = tid >> 6, wr = wid >> 1, wc = wid & 1;
  const int fr = lane & 15, fq = lane >> 4;
  const bf16_t* A; const bf16_t* Bt;
  if (MODE == 0) { A = p.xb; Bt = p.wTin + (size_t)layer * INC * 1024; }
  else if (MODE == 1) { A = p.memb; Bt = p.wTkv + (size_t)layer * 512 * 1024; }
  else { A = p.mixed; Bt = p.wTout + (size_t)layer * 1024 * 1024; }
  const bf16_t* Ag = A + (size_t)(mt * (MT * 32)) * 1024;
  const bf16_t* Bg = Bt + (size_t)(nt * 128) * 1024;
  f32x4 acc[MT][4];
#pragma unroll
  for (int m = 0; m < MT; ++m)
#pragma unroll
    for (int n = 0; n < 4; ++n) acc[m][n] = f32x4{0.f, 0.f, 0.f, 0.f};
  constexpr int NLD = (MT == 8) ? 6 : 4;
  u32x4 rgA[NLD], rgB[NLD];
  const unsigned goff0 = (unsigned)((tid >> 2) * 2048 + (((tid & 3) ^ (((tid >> 5) & 1) * 3)) * 16));
  const int sbase = tid * 16;
  const char* Ab = (const char*)Ag; const char* Bb = (const char*)Bg;
#define G_LOAD(R, KT) _Pragma("unroll") for (int i = 0; i < NLD; ++i) { \
    const int ii = (MT == 8) ? i : (i < 2 ? i : i + 2); \
    const char* gb = ((ii < 4) ? Ab + ii * 131072 : Bb + (ii - 4) * 131072) + (KT) * 64; \
    R[i] = *(const u32x4*)(gb + goff0); }
#define G_STORE(R, ST) _Pragma("unroll") for (int i = 0; i < NLD; ++i) { \
    const int ii = (MT == 8) ? i : (i < 2 ? i : i + 2); \
    *(u32x4*)((ST) + ii * 4096 + sbase) = R[i]; }
#define G_COMPUTE(ST) { const char* st = (ST); bf16x8 b[4], a[MT]; \
    _Pragma("unroll") for (int n = 0; n < 4; ++n) b[n] = *(const bf16x8*)(st + boff + (n >> 1) * 2048 + (n & 1) * 256); \
    _Pragma("unroll") for (int m = 0; m < MT; ++m) a[m] = *(const bf16x8*)(st + aoff + m * 1024); \
    __builtin_amdgcn_s_setprio(1); \
    _Pragma("unroll") for (int m = 0; m < MT; ++m) \
      _Pragma("unroll") for (int n = 0; n < 4; ++n) acc[m][n] = __builtin_amdgcn_mfma_f32_16x16x32_bf16(b[n], a[m], acc[m][n], 0, 0, 0); \
    __builtin_amdgcn_s_setprio(0); }
  const int aoff = (wr * (MT * 16) + fr) * 64 + ((fq ^ (((fr >> 3) & 1) * 3)) & 3) * 16;
  const int boff = 16384 + (wc * 64 + 8 * (fr >> 2) + (fr & 3)) * 64 + ((fq ^ (((fr >> 2) & 1) * 3)) & 3) * 16;
  G_LOAD(rgA, 0)
  G_STORE(rgA, smem)
  G_LOAD(rgA, 1)
  G_LOAD(rgB, 2)
#pragma unroll 1
  for (int kt = 0; kt < 32; kt += 2) {
    __syncthreads();
    G_STORE(rgA, smem + G_STAGE)
    if (kt + 3 < 32) G_LOAD(rgA, kt + 3)
    G_COMPUTE(smem)
    __syncthreads();
    if (kt + 2 < 32) G_STORE(rgB, smem)
    if (kt + 4 < 32) G_LOAD(rgB, kt + 4)
    G_COMPUTE(smem + G_STAGE)
  }
#undef G_LOAD
#undef G_STORE
#undef G_COMPUTE
  const int cb = nt * 128 + wc * 64;
  const int rb0 = mt * (MT * 32) + wr * (MT * 16);
  if (MODE == 0) {
    const bool rot = (cb >= C_MBQ && cb < C_MBV);
    const bool km = (cb >= C_MBK && cb < C_MBV);
    f32x4 colsum[4];
#pragma unroll
    for (int n = 0; n < 4; ++n) colsum[n] = f32x4{0.f, 0.f, 0.f, 0.f};
    float rsv[MT];
#pragma unroll
    for (int m = 0; m < MT; ++m) rsv[m] = p.ss[layer * NTOK + rb0 + m * 16 + fr];
#pragma unroll
    for (int m = 0; m < MT; ++m) rsv[m] = rsqrtf(rsv[m] * (1.f / 1024.f) + 1e-6f);
#pragma unroll
    for (int m = 0; m < MT; ++m) {
      const int grow = rb0 + m * 16 + fr;
      const float rs = rsv[m];
#pragma unroll
      for (int pp = 0; pp < 2; ++pp) {
        f32x4 v0 = acc[m][2 * pp] * rs, v1 = acc[m][2 * pp + 1] * rs;
        if (pp == 0 && rot) {
          const int pos = grow & (T - 1);
          const float4 c0 = *(const float4*)(p.costab + pos * 8), c1 = *(const float4*)(p.costab + pos * 8 + 4);
          const float4 s0 = *(const float4*)(p.sintab + pos * 8), s1 = *(const float4*)(p.sintab + pos * 8 + 4);
          const float cc[8] = {c0.x, c0.y, c0.z, c0.w, c1.x, c1.y, c1.z, c1.w};
          const float sn[8] = {s0.x, s0.y, s0.z, s0.w, s1.x, s1.y, s1.z, s1.w};
#pragma unroll
          for (int j = 0; j < 4; ++j) {
            const float p0 = shfl16(v0[j]), p1 = shfl16(v1[j]);
            const float r0 = (fq == 0) ? (v0[j] * cc[j] - p0 * sn[j]) : (v0[j] * cc[j] + p0 * sn[j]);
            const float r1 = (fq == 0) ? (v1[j] * cc[4 + j] - p1 * sn[4 + j]) : (v1[j] * cc[4 + j] + p1 * sn[4 + j]);
            v0[j] = (fq < 2) ? r0 : v0[j];
            v1[j] = (fq < 2) ? r1 : v1[j];
          }
        }
        if (km) { colsum[2 * pp] += v0; colsum[2 * pp + 1] += v1; }
        uint4 o; o.x = pack2(v0[0], v0[1]); o.y = pack2(v0[2], v0[3]); o.z = pack2(v1[0], v1[1]); o.w = pack2(v1[2], v1[3]);
        *(uint4*)(p.proj + (size_t)grow * INC + cb + pp * 32 + fq * 8) = o;
      }
      if (m & 1) asm volatile("" ::: "memory");
    }
    if (km) {
      const int b = rb0 / T, blk = (rb0 % T) / 256;
#pragma unroll
      for (int n = 0; n < 4; ++n)
#pragma unroll
        for (int j = 0; j < 4; ++j) {
          float sm = colsum[n][j];
          sm += __shfl_xor(sm, 1); sm += __shfl_xor(sm, 2); sm += __shfl_xor(sm, 4); sm += __shfl_xor(sm, 8);
          if (fr == 0) atomicAdd(&p.kmean[((layer * 8 + b) * 8 + blk) * 384 + (cb - C_MBK) + (n >> 1) * 32 + fq * 8 + (n & 1) * 4 + j], sm);
        }
    }
  } else if (MODE == 1) {
    float rsv[MT];
#pragma unroll
    for (int m = 0; m < MT; ++m) rsv[m] = p.memss[rb0 + m * 16 + fr];
#pragma unroll
    for (int m = 0; m < MT; ++m) rsv[m] = rsqrtf(rsv[m] * (1.f / 1024.f) + 1e-6f);
#pragma unroll
    for (int m = 0; m < MT; ++m) {
      const int grow = rb0 + m * 16 + fr;
#pragma unroll
      for (int pp = 0; pp < 2; ++pp) {
        f32x4 v0 = acc[m][2 * pp] * rsv[m], v1 = acc[m][2 * pp + 1] * rsv[m];
        uint4 o; o.x = pack2(v0[0], v0[1]); o.y = pack2(v0[2], v0[3]); o.z = pack2(v1[0], v1[1]); o.w = pack2(v1[2], v1[3]);
        *(uint4*)(p.mkv + (size_t)layer * NMEM * 512 + (size_t)grow * 512 + cb + pp * 32 + fq * 8) = o;
      }
      if (m & 1) asm volatile("" ::: "memory");
    }
  } else {
    if (layer == 0) {
#pragma unroll
      for (int mp = 0; mp < MT / 2; ++mp) {
        uint4 xo[2][2];
#pragma unroll
        for (int h2 = 0; h2 < 2; ++h2)
#pragma unroll
          for (int pp = 0; pp < 2; ++pp)
            xo[h2][pp] = *(const uint4*)(p.xb + (size_t)(rb0 + (mp * 2 + h2) * 16 + fr) * 1024 + cb + pp * 32 + fq * 8);
#pragma unroll
        for (int h2 = 0; h2 < 2; ++h2) {
          const int m = mp * 2 + h2;
          const int grow = rb0 + m * 16 + fr;
          float sq = 0.f;
#pragma unroll
          for (int pp = 0; pp < 2; ++pp) {
            const size_t idx = (size_t)grow * 1024 + cb + pp * 32 + fq * 8;
            const uint4 u = xo[h2][pp];
            float4 xa, xc;
            xa.x = bflo(u.x) + acc[m][2 * pp][0]; xa.y = bfhi(u.x) + acc[m][2 * pp][1];
            xa.z = bflo(u.y) + acc[m][2 * pp][2]; xa.w = bfhi(u.y) + acc[m][2 * pp][3];
            xc.x = bflo(u.z) + acc[m][2 * pp + 1][0]; xc.y = bfhi(u.z) + acc[m][2 * pp + 1][1];
            xc.z = bflo(u.w) + acc[m][2 * pp + 1][2]; xc.w = bfhi(u.w) + acc[m][2 * pp + 1][3];
            uint4 o; o.x = pack2(xa.x, xa.y); o.y = pack2(xa.z, xa.w); o.z = pack2(xc.x, xc.y); o.w = pack2(xc.z, xc.w);
            *(uint4*)(p.xb + idx) = o;
            sq += xa.x * xa.x + xa.y * xa.y + xa.z * xa.z + xa.w * xa.w + xc.x * xc.x + xc.y * xc.y + xc.z * xc.z + xc.w * xc.w;
          }
          sq += shfl16(sq); sq += shfl32(sq);
          if (fq == 0) atomicAdd(&p.ss[NTOK + grow], sq);
        }
        asm volatile("" ::: "memory");
      }
    } else {
#pragma unroll
      for (int mp = 0; mp < MT / 2; ++mp) {
        uint4 xo[2][2];
#pragma unroll
        for (int h2 = 0; h2 < 2; ++h2)
#pragma unroll
          for (int pp = 0; pp < 2; ++pp)
            xo[h2][pp] = *(const uint4*)(p.xb + (size_t)(rb0 + (mp * 2 + h2) * 16 + fr) * 1024 + cb + pp * 32 + fq * 8);
#pragma unroll
        for (int h2 = 0; h2 < 2; ++h2) {
          const int m = mp * 2 + h2;
          const int grow = rb0 + m * 16 + fr;
          float sq = 0.f;
#pragma unroll
          for (int pp = 0; pp < 2; ++pp) {
            const size_t idx = (size_t)grow * 1024 + cb + pp * 32 + fq * 8;
            const uint4 u = xo[h2][pp];
            float4 xa, xc;
            xa.x = bflo(u.x) + acc[m][2 * pp][0]; xa.y = bfhi(u.x) + acc[m][2 * pp][1];
            xa.z = bflo(u.y) + acc[m][2 * pp][2]; xa.w = bfhi(u.y) + acc[m][2 * pp][3];
            xc.x = bflo(u.z) + acc[m][2 * pp + 1][0]; xc.y = bfhi(u.z) + acc[m][2 * pp + 1][1];
            xc.z = bflo(u.w) + acc[m][2 * pp + 1][2]; xc.w = bfhi(u.w) + acc[m][2 * pp + 1][3];
            { uint4 o; o.x = pack2(xa.x, xa.y); o.y = pack2(xa.z, xa.w); o.z = pack2(xc.x, xc.y); o.w = pack2(xc.z, xc.w);
              *(uint4*)(p.xb + idx) = o; }
            sq += xa.x * xa.x + xa.y * xa.y + xa.z * xa.z + xa.w * xa.w + xc.x * xc.x + xc.y * xc.y + xc.z * xc.z + xc.w * xc.w;
          }
          sq += shfl16(sq); sq += shfl32(sq);
          if (fq == 0) atomicAdd(&p.ss[2 * NTOK + grow], sq);
        }
        asm volatile("" ::: "memory");
      }
    }
  }
}

DI void load_row64(const bf16_t* __restrict__ ptr, float (&r)[64], float scale) {
#pragma unroll
  for (int i = 0; i < 8; ++i) {
    uint4 u = *(const uint4*)(ptr + i * 8);
    r[i * 8 + 0] = bflo(u.x) * scale; r[i * 8 + 1] = bfhi(u.x) * scale;
    r[i * 8 + 2] = bflo(u.y) * scale; r[i * 8 + 3] = bfhi(u.y) * scale;
    r[i * 8 + 4] = bflo(u.z) * scale; r[i * 8 + 5] = bfhi(u.z) * scale;
    r[i * 8 + 6] = bflo(u.w) * scale; r[i * 8 + 7] = bfhi(u.w) * scale;
  }
}
DI float dot_row64(const bf16_t* __restrict__ ptr, const float (&q)[64]) {
  float z = 0.f;
#pragma unroll
  for (int i = 0; i < 8; ++i) {
    uint4 u = *(const uint4*)(ptr + i * 8);
    z += q[i * 8 + 0] * bflo(u.x); z += q[i * 8 + 1] * bfhi(u.x);
    z += q[i * 8 + 2] * bflo(u.y); z += q[i * 8 + 3] * bfhi(u.y);
    z += q[i * 8 + 4] * bflo(u.z); z += q[i * 8 + 5] * bfhi(u.z);
    z += q[i * 8 + 6] * bflo(u.w); z += q[i * 8 + 7] * bfhi(u.w);
  }
  return z;
}
DI void axpy_row64(const bf16_t* __restrict__ ptr, float w, float (&acc)[64]) {
#pragma unroll
  for (int i = 0; i < 8; ++i) {
    uint4 u = *(const uint4*)(ptr + i * 8);
    acc[i * 8 + 0] += w * bflo(u.x); acc[i * 8 + 1] += w * bfhi(u.x);
    acc[i * 8 + 2] += w * bflo(u.y); acc[i * 8 + 3] += w * bfhi(u.y);
    acc[i * 8 + 4] += w * bflo(u.z); acc[i * 8 + 5] += w * bfhi(u.z);
    acc[i * 8 + 6] += w * bflo(u.w); acc[i * 8 + 7] += w * bfhi(u.w);
  }
}
DI void gate_store(const bf16_t* __restrict__ gp, bf16_t* __restrict__ op, const float (&acc)[64], float scale) {
#pragma unroll
  for (int i = 0; i < 8; ++i) {
    uint4 u = *(const uint4*)(gp + i * 8);
    float g[8] = {bflo(u.x), bfhi(u.x), bflo(u.y), bfhi(u.y), bflo(u.z), bfhi(u.z), bflo(u.w), bfhi(u.w)};
    float o[8];
#pragma unroll
    for (int e = 0; e < 8; ++e) o[e] = acc[i * 8 + e] * scale * (g[e] / (1.f + __expf(-g[e])));
    uint4 w; w.x = pack2(o[0], o[1]); w.y = pack2(o[2], o[3]); w.z = pack2(o[4], o[5]); w.w = pack2(o[6], o[7]);
    *(uint4*)(op + i * 8) = w;
  }
}

DI void sb_naive_wave(const Params& p, int layer, int item, int lane) {
  const int qc = 31 - (item & 31), bh = item >> 5, h = bh % 6, b = bh / 6;
  const int t = qc * 64 + lane;
  const bf16_t* base = p.proj + (size_t)(b * T) * INC;
  float q[64], acc[64];
  load_row64(base + (size_t)t * INC + C_SBQ + h * 64, q, 0.125f);
#pragma unroll
  for (int d = 0; d < 64; ++d) acc[d] = 0.f;
  float carry = 0.f;
  for (int s = qc * 64 + 62; s >= 0; --s) {
    const bf16_t* kp = base + (size_t)s * INC + C_SBK + h * 64;
    float z = dot_row64(kp, q);
    bool act = s < t;
    float lb = fminf(z, 0.f) - log1pf(expf(-fabsf(z)));
    float w = act ? expf(lb + carry) : 0.f;
    carry += act ? (lb - z) : 0.f;
    axpy_row64(kp + (C_SBV - C_SBK), w, acc);
  }
  gate_store(base + (size_t)t * INC + C_SBG + h * 64, p.mixed + (size_t)(b * T + t) * 1024 + h * 64, acc, 1.f);
}

DI void os_step(const float (&q)[64], float& m, float& l, float (&acc)[64], const bf16_t* kp, const bf16_t* vp, bool valid) {
  float sc = dot_row64(kp, q);
  sc = valid ? sc : -1e30f;
  float mn = fmaxf(m, sc);
  float alpha = __expf(m - mn);
  float pw = valid ? __expf(sc - mn) : 0.f;
  l = l * alpha + pw;
  m = mn;
#pragma unroll
  for (int d = 0; d < 64; ++d) acc[d] *= alpha;
  axpy_row64(vp, pw, acc);
}

DI void moba_naive_wave(const Params& p, int layer, int item, int lane) {
  const int qc = 31 - (item & 31), bh = item >> 5, h = bh % 6, b = bh / 6;
  const int t = qc * 64 + lane, own = qc >> 2;
  const bf16_t* base = p.proj + (size_t)(b * T) * INC;
  float q[64], acc[64];
  load_row64(base + (size_t)t * INC + C_MBQ + h * 64, q, 1.f);
  unsigned sel = 0;
  if (own <= 3) sel = (1u << own) - 1u;
  else {
    float gate[8];
#pragma unroll
    for (int j = 0; j < 8; ++j) {
      float gsum = 0.f;
      if (j < own) {
        const float* km = p.kmean + ((layer * 8 + b) * 8 + j) * 384 + h * 64;
#pragma unroll
        for (int d = 0; d < 64; ++d) gsum += q[d] * km[d];
      }
      gate[j] = gsum;
    }
#pragma unroll
    for (int r = 0; r < 3; ++r) {
      float best = -3.0e38f; int bi = 0;
#pragma unroll
      for (int j = 0; j < 8; ++j) {
        bool ok = (j < own) && !((sel >> j) & 1u) && (gate[j] > best);
        best = ok ? gate[j] : best; bi = ok ? j : bi;
      }
      sel |= 1u << bi;
    }
  }
#pragma unroll
  for (int d = 0; d < 64; ++d) { acc[d] = 0.f; q[d] *= 0.125f; }
  float m = -1e30f, l = 0.f;
  for (int j = 0; j < own; ++j) {
    bool v = (sel >> j) & 1u;
    if (__ballot(v) == 0ull) continue;
    for (int s = j * 256; s < j * 256 + 256; ++s) {
      const bf16_t* kp = base + (size_t)s * INC + C_MBK + h * 64;
      os_step(q, m, l, acc, kp, kp + (C_MBV - C_MBK), v);
    }
  }
  for (int s = own * 256; s <= qc * 64 + 63; ++s) {
    const bf16_t* kp = base + (size_t)s * INC + C_MBK + h * 64;
    os_step(q, m, l, acc, kp, kp + (C_MBV - C_MBK), s <= t);
  }
  gate_store(base + (size_t)t * INC + C_MBG + h * 64, p.mixed + (size_t)(b * T + t) * 1024 + 384 + h * 64, acc, 1.f / l);
}

DI void mem_naive_wave(const Params& p, int layer, int item, int lane) {
  const int qc = item & 31, bh = item >> 5, h = bh & 3, b = bh >> 2;
  const int t = qc * 64 + lane;
  const bf16_t* base = p.proj + (size_t)(b * T) * INC;
  float q[64], acc[64];
  load_row64(base + (size_t)t * INC + C_MQ + h * 64, q, 0.125f);
#pragma unroll
  for (int d = 0; d < 64; ++d) acc[d] = 0.f;
  float m = -1e30f, l = 0.f;
  const bf16_t* kv = p.mkv + (size_t)layer * NMEM * 512 + (size_t)(b * MEML) * 512 + h * 64;
  for (int s = 0; s < MEML; ++s) os_step(q, m, l, acc, kv + (size_t)s * 512, kv + (size_t)s * 512 + 256, true);
  gate_store(base + (size_t)t * INC + C_MG + h * 64, p.mixed + (size_t)(b * T + t) * 1024 + 768 + h * 64, acc, 1.f / l);
}

__global__ void __launch_bounds__(256) attn_naive_sb(Params p, int layer) {
  sb_naive_wave(p, layer, blockIdx.x * 4 + (threadIdx.x >> 6), threadIdx.x & 63);
}
__global__ void __launch_bounds__(256) attn_naive_moba(Params p, int layer) {
  moba_naive_wave(p, layer, blockIdx.x * 4 + (threadIdx.x >> 6), threadIdx.x & 63);
}
__global__ void __launch_bounds__(256) attn_naive_mem(Params p, int layer) {
  mem_naive_wave(p, layer, blockIdx.x * 4 + (threadIdx.x >> 6), threadIdx.x & 63);
}

constexpr int AT_STR = 72;
constexpr float C2 = 0.125f * 1.4426950408889634f;

DI bf16x8 pack8(const f32x4& a, const f32x4& b) {
  u32x4 r;
  r[0] = pack2(a[0], a[1]); r[1] = pack2(a[2], a[3]); r[2] = pack2(b[0], b[1]); r[3] = pack2(b[2], b[3]);
  return __builtin_bit_cast(bf16x8, r);
}

struct TileSrc { const bf16_t* k; int kstride; const bf16_t* v; };

DI void tile_gload(const TileSrc& ts, int k0, int tid, u32x4 (&rk)[2], u32x4 (&rv)[2]) {
  const unsigned toff = (unsigned)((tid >> 3) * ts.kstride * 2 + (tid & 7) * 16);
#pragma unroll
  for (int i = 0; i < 2; ++i) {
    const char* kb = (const char*)ts.k + (size_t)(k0 + 32 * i) * ts.kstride * 2;
    const char* vb = (const char*)ts.v + (size_t)(k0 + 32 * i) * ts.kstride * 2;
    rk[i] = *(const u32x4*)(kb + toff);
    rv[i] = *(const u32x4*)(vb + toff);
  }
}
DI void tile_sstore(bf16_t* Ks, bf16_t* Vs, int tid, const u32x4 (&rk)[2], const u32x4 (&rv)[2]) {
#pragma unroll
  for (int i = 0; i < 2; ++i) {
    int c = tid + i * 256, row = c >> 3, ch = c & 7;
    int kk = row & 31;
    int rho = (row & 32) + ((kk >> 2) & 1) * 16 + (kk >> 3) * 4 + (kk & 3);
    *(u32x4*)(Ks + rho * AT_STR + ch * 8) = rk[i];
    *(u32x4*)(Vs + row * AT_STR + ch * 8) = rv[i];
  }
}

DI void st_mfma(const bf16_t* Ks, const bf16x8 (&qf)[2], f32x4 (&s)[4], int fr, int fq) {
#pragma unroll
  for (int i = 0; i < 4; ++i) {
    bf16x8 a0 = *(const bf16x8*)(Ks + (i * 16 + fr) * AT_STR + fq * 8);
    bf16x8 a1 = *(const bf16x8*)(Ks + (i * 16 + fr) * AT_STR + 32 + fq * 8);
    f32x4 z = {0.f, 0.f, 0.f, 0.f};
    z = __builtin_amdgcn_mfma_f32_16x16x32_bf16(a0, qf[0], z, 0, 0, 0);
    z = __builtin_amdgcn_mfma_f32_16x16x32_bf16(a1, qf[1], z, 0, 0, 0);
    s[i] = z;
  }
}
typedef short s16x4_t __attribute__((ext_vector_type(4)));
DI void pv_mfma(const bf16_t* Vs, const bf16x8 (&pw)[2][2], f32x4 (&o)[2][4], int fr, int fq) {
  const int q = fr >> 2, pp = fr & 3;
#pragma unroll
  for (int dt = 0; dt < 4; ++dt) {
#pragma unroll
    for (int st = 0; st < 2; ++st) {
      const bf16_t* a0p = Vs + (st * 32 + fq * 8 + q) * AT_STR + dt * 16 + 4 * pp;
      s16x4_t lo = __builtin_amdgcn_ds_read_tr16_b64_v4i16((__attribute__((address_space(3))) s16x4_t*)(a0p));
      s16x4_t hi = __builtin_amdgcn_ds_read_tr16_b64_v4i16((__attribute__((address_space(3))) s16x4_t*)(a0p + 4 * AT_STR));
      bf16x8 a = __builtin_shufflevector(lo, hi, 0, 1, 2, 3, 4, 5, 6, 7);
#pragma unroll
      for (int qg = 0; qg < 2; ++qg) o[qg][dt] = __builtin_amdgcn_mfma_f32_16x16x32_bf16(a, pw[qg][st], o[qg][dt], 0, 0, 0);
    }
  }
}

template <int KIND>
DI void attn_item(const Params& p, int layer, int item, char* smem, int g_tid) {
  const int tid = g_tid, lane = tid & 63, wid = tid >> 6, fr = lane & 15, fq = lane >> 4;
  bf16_t* Ksb[2]; bf16_t* Vsb[2];
  Ksb[0] = (bf16_t*)smem; Vsb[0] = Ksb[0] + 64 * AT_STR; Ksb[1] = Vsb[0] + 64 * AT_STR; Vsb[1] = Ksb[1] + 64 * AT_STR;
  unsigned* sU = (unsigned*)(smem + 4 * 64 * AT_STR * 2);
  int b, h, qt;
  const bf16_t *qbase, *gbase; bf16_t* obase; TileSrc ts;
  if (KIND == 0) {
    qt = 15 - (item & 15); int bh = item >> 4; h = bh % 6; b = bh / 6;
    const bf16_t* pb = p.proj + (size_t)(b * T) * INC;
    qbase = pb + C_SBQ + h * 64; gbase = pb + C_SBG + h * 64; ts.k = pb + C_SBK + h * 64; ts.kstride = INC;
    ts.v = pb + C_SBV + h * 64;
    obase = p.mixed + (size_t)(b * T) * 1024 + h * 64;
  } else if (KIND == 1) {
    qt = 15 - (item & 15); int bh = item >> 4; h = bh % 6; b = bh / 6;
    const bf16_t* pb = p.proj + (size_t)(b * T) * INC;
    qbase = pb + C_MBQ + h * 64; gbase = pb + C_MBG + h * 64; ts.k = pb + C_MBK + h * 64; ts.kstride = INC;
    ts.v = pb + C_MBV + h * 64;
    obase = p.mixed + (size_t)(b * T) * 1024 + 384 + h * 64;
  } else {
    qt = item & 15; int bh = item >> 4; h = bh & 3; b = bh >> 2;
    const bf16_t* pb = p.proj + (size_t)(b * T) * INC;
    qbase = pb + C_MQ + h * 64; gbase = pb + C_MG + h * 64;
    ts.k = p.mkv + (size_t)layer * NMEM * 512 + (size_t)(b * MEML) * 512 + h * 64; ts.kstride = 512;
    ts.v = ts.k + 256;
    obase = p.mixed + (size_t)(b * T) * 1024 + 768 + h * 64;
  }
  const int q0 = qt * 128;
  const int tmin = q0 + wid * 32, tmax = tmin + 31;
  bf16x8 qf[2][2];
#pragma unroll
  for (int qg = 0; qg < 2; ++qg)
#pragma unroll
    for (int ks = 0; ks < 2; ++ks)
      qf[qg][ks] = *(const bf16x8*)(qbase + (size_t)(tmin + qg * 16 + fr) * INC + ks * 32 + fq * 8);

  const int own = q0 >> 8, own_start = own << 8;
  u32x4 rk[2], rv[2], rk2[2], rv2[2];
  tile_gload(ts, KIND == 0 ? ((q0 >> 6) + 1) * 64 : (KIND == 1 ? own_start : 0), tid, rk, rv);
  int ntile; unsigned U = 0; int n_own = 0;
  unsigned sel[2] = {0u, 0u};
  if (KIND == 0) ntile = (q0 >> 6) + 2;
  else if (KIND == 2) ntile = 4;
  else {
    n_own = ((q0 - own_start) >> 6) + 2;
    if (own <= 3) { U = (1u << own) - 1u; sel[0] = sel[1] = U; }
    else {
      f32x4 ga[2];
      ga[0] = f32x4{0.f, 0.f, 0.f, 0.f}; ga[1] = ga[0];
#pragma unroll
      for (int ks = 0; ks < 2; ++ks) {
        float kmv[8];
        const float* kmp = p.kmean + (size_t)((layer * 8 + b) * 8 + (fr & 7)) * 384 + h * 64 + ks * 32 + fq * 8;
        float4 k0v = *(const float4*)kmp, k1v = *(const float4*)(kmp + 4);
        kmv[0] = k0v.x; kmv[1] = k0v.y; kmv[2] = k0v.z; kmv[3] = k0v.w; kmv[4] = k1v.x; kmv[5] = k1v.y; kmv[6] = k1v.z; kmv[7] = k1v.w;
        u32x4 hi, lo;
#pragma unroll
        for (int e = 0; e < 4; ++e) {
          float x0 = (fr < 8) ? kmv[2 * e] : 0.f, x1 = (fr < 8) ? kmv[2 * e + 1] : 0.f;
          bf16_t h0 = f2bf(x0), h1 = f2bf(x1);
          hi[e] = (unsigned)h0 | ((unsigned)h1 << 16);
          lo[e] = pack2(x0 - bf2f(h0), x1 - bf2f(h1));
        }
        bf16x8 ah = __builtin_bit_cast(bf16x8, hi), al = __builtin_bit_cast(bf16x8, lo);
#pragma unroll
        for (int qg = 0; qg < 2; ++qg) {
          ga[qg] = __builtin_amdgcn_mfma_f32_16x16x32_bf16(ah, qf[qg][ks], ga[qg], 0, 0, 0);
          ga[qg] = __builtin_amdgcn_mfma_f32_16x16x32_bf16(al, qf[qg][ks], ga[qg], 0, 0, 0);
        }
      }
#pragma unroll
      for (int qg = 0; qg < 2; ++qg) {
        float gate[8];
#pragma unroll
        for (int j = 0; j < 4; ++j) {
          float mine = ga[qg][j], oth = shfl16(mine);
          gate[j] = (fq & 1) ? oth : mine;
          gate[4 + j] = (fq & 1) ? mine : oth;
        }
        unsigned sl = 0;
#pragma unroll
        for (int r = 0; r < 3; ++r) {
          float best = -3.0e38f; int bi = 0;
#pragma unroll
          for (int j = 0; j < 8; ++j) {
            bool ok = (j < own) && !((sl >> j) & 1u) && (gate[j] > best);
            best = ok ? gate[j] : best; bi = ok ? j : bi;
          }
          sl |= 1u << bi;
        }
        sl = __shfl(sl, lane & 31);
        sel[qg] = sl;
      }
      unsigned u = sel[0] | sel[1];
#pragma unroll
      for (int o = 32; o >= 1; o >>= 1) u |= __shfl_xor(u, o);
      __syncthreads();
      if (tid == 0) *sU = 0u;
      __syncthreads();
      if (lane == 0) atomicOr(sU, u);
      __syncthreads();
      U = *sU;
    }
    ntile = n_own + 4 * __popc(U);
  }
  auto tile_k0 = [&](int i) -> int {
    if (KIND == 0) return (ntile - 1 - i) * 64;
    if (KIND == 2) return i * 64;
    if (i < n_own) return own_start + i * 64;
    int ii = i - n_own, nb = ii >> 2, blk = 0; unsigned u = U;
    for (int c = 0; c < nb; ++c) u &= u - 1;
    blk = __ffs(u) - 1;
    return blk * 256 + (ii & 3) * 64;
  };

  f32x4 o[2][4];
#pragma unroll
  for (int qg = 0; qg < 2; ++qg)
#pragma unroll
    for (int dt = 0; dt < 4; ++dt) o[qg][dt] = f32x4{0.f, 0.f, 0.f, 0.f};
  float carry[2] = {1.f, 1.f};
  float mrun[2] = {-1e30f, -1e30f}, lrun[2] = {0.f, 0.f};

  __syncthreads();
  tile_sstore(Ksb[0], Vsb[0], tid, rk, rv);
  if (ntile > 1) tile_gload(ts, tile_k0(1), tid, rk, rv);
  __syncthreads();
  auto step = [&](const int i, u32x4 (&lk)[2], u32x4 (&lv)[2], const u32x4 (&sk)[2], const u32x4 (&sv2)[2]) -> bool {
    const int k0 = tile_k0(i);
    const bf16_t* Ks = Ksb[i & 1]; const bf16_t* Vs = Vsb[i & 1];
    if (i + 2 < ntile) tile_gload(ts, tile_k0(i + 2), tid, lk, lv);
    bool skip = false, diag = false;
    if (KIND == 0) { skip = (k0 >= tmax); diag = (k0 + 63 >= tmin); }
    if (KIND == 1 && i < n_own) { skip = (k0 > tmax); diag = (k0 + 63 > tmin); }
    if (!skip) {
      bf16x8 pw[2][2];
      if (KIND == 0) {
#pragma unroll
        for (int qg = 0; qg < 2; ++qg) {
          const int t = tmin + qg * 16 + fr;
          f32x4 s[4];
          st_mfma(Ks, qf[qg], s, fr, fq);
          float om[16], be[16];
#pragma unroll
          for (int ii = 0; ii < 4; ++ii)
#pragma unroll
            for (int j = 0; j < 4; ++j) {
              const int e = ii * 4 + j;
              float z2 = fmaxf(s[ii][j] * C2, -100.f);
              float ex = __builtin_amdgcn_exp2f(-z2);
              float r = __builtin_amdgcn_rcpf(1.f + ex);
              be[e] = r; om[e] = ex * r;
            }
          if (diag) {
            asm volatile("" ::: "memory");
#pragma unroll
            for (int ii = 0; ii < 4; ++ii)
#pragma unroll
              for (int j = 0; j < 4; ++j) {
                const int e = ii * 4 + j;
                const int key = k0 + (ii >> 1) * 32 + 8 * fq + (ii & 1) * 4 + j;
                const bool act = key < t;
                be[e] = act ? be[e] : 0.f; om[e] = act ? om[e] : 1.f;
              }
          }
          float cp0 = om[0], cp1 = om[8];
#pragma unroll
          for (int e = 1; e < 8; ++e) { cp0 *= om[e]; cp1 *= om[8 + e]; }
          float a0 = shfl16(cp0), a1 = shfl16(cp1);
          float pr0 = cp0 * a0, pr1 = cp1 * a1;
          float b0 = shfl32(pr0), b1 = shfl32(pr1);
          float tot0 = pr0 * b0, tot1 = pr1 * b1;
          float sfx0 = (fq == 0) ? a0 * b0 : (fq == 1) ? b0 : (fq == 2) ? a0 : 1.f;
          float sfx1 = (fq == 0) ? a1 * b1 : (fq == 1) ? b1 : (fq == 2) ? a1 : 1.f;
          float w[16];
          float P = carry[qg] * sfx1;
#pragma unroll
          for (int e = 15; e >= 8; --e) { w[e] = be[e] * P; P *= om[e]; }
          P = carry[qg] * tot1 * sfx0;
#pragma unroll
          for (int e = 7; e >= 0; --e) { w[e] = be[e] * P; P *= om[e]; }
          carry[qg] *= tot1 * tot0;
          f32x4 w0 = {w[0], w[1], w[2], w[3]}, w1 = {w[4], w[5], w[6], w[7]};
          f32x4 w2 = {w[8], w[9], w[10], w[11]}, w3 = {w[12], w[13], w[14], w[15]};
          pw[qg][0] = pack8(w0, w1); pw[qg][1] = pack8(w2, w3);
        }
      } else {
#pragma unroll
        for (int qg = 0; qg < 2; ++qg) {
          const int t = tmin + qg * 16 + fr;
          f32x4 s[4];
          st_mfma(Ks, qf[qg], s, fr, fq);
          float sv[16];
          bool lanevalid = true;
          if (KIND == 1 && i >= n_own) lanevalid = (sel[qg] >> (k0 >> 8)) & 1u;
          float mx = -3.0e38f;
#pragma unroll
          for (int ii = 0; ii < 4; ++ii)
#pragma unroll
            for (int j = 0; j < 4; ++j) {
              const int e = ii * 4 + j;
              sv[e] = s[ii][j];
            }
          if (KIND == 1 && diag) {
            asm volatile("" ::: "memory");
#pragma unroll
            for (int ii = 0; ii < 4; ++ii)
#pragma unroll
              for (int j = 0; j < 4; ++j) {
                const int key = k0 + (ii >> 1) * 32 + 8 * fq + (ii & 1) * 4 + j;
                sv[ii * 4 + j] = (key <= t) ? sv[ii * 4 + j] : -3.0e38f;
              }
          }
#pragma unroll
          for (int e = 0; e < 16; ++e) mx = fmaxf(mx, sv[e]);
          mx = lanevalid ? mx : -3.0e38f;
          mx = fmaxf(mx, shfl16(mx));
          mx = fmaxf(mx, shfl32(mx));
          const float mnew = fmaxf(mrun[qg], mx * C2);
          const float alpha = __builtin_amdgcn_exp2f(mrun[qg] - mnew);
          mrun[qg] = mnew;
          const float c2e = lanevalid ? C2 : 0.f, nb = lanevalid ? -mnew : -1e30f;
          float ps = 0.f;
#pragma unroll
          for (int e = 0; e < 16; ++e) { sv[e] = __builtin_amdgcn_exp2f(__builtin_fmaf(sv[e], c2e, nb)); ps += sv[e]; }
          lrun[qg] = lrun[qg] * alpha + ps;
          if (__any(alpha != 1.f)) {
#pragma unroll
            for (int dt = 0; dt < 4; ++dt) o[qg][dt] *= alpha;
          }
          f32x4 w0 = {sv[0], sv[1], sv[2], sv[3]}, w1 = {sv[4], sv[5], sv[6], sv[7]};
          f32x4 w2 = {sv[8], sv[9], sv[10], sv[11]}, w3 = {sv[12], sv[13], sv[14], sv[15]};
          pw[qg][0] = pack8(w0, w1); pw[qg][1] = pack8(w2, w3);
        }
      }
      pv_mfma(Vs, pw, o, fr, fq);
    }
    if (i + 1 < ntile) tile_sstore(Ksb[(i + 1) & 1], Vsb[(i + 1) & 1], tid, sk, sv2);
    if (KIND == 0) {
      const int live = (carry[0] >= 1.17549435e-38f) || (carry[1] >= 1.17549435e-38f);
      if (!__syncthreads_or(live)) return true;
    } else {
      __syncthreads();
    }
    return false;
  };
#pragma unroll 1
  for (int i = 0; i < ntile; i += 2) {
    if (step(i, rk2, rv2, rk, rv)) break;
    if (i + 1 < ntile) { if (step(i + 1, rk, rv, rk2, rv2)) break; }
  }
#pragma unroll
  for (int qg = 0; qg < 2; ++qg) {
    const int t = tmin + qg * 16 + fr;
    float scale = 1.f;
    if (KIND != 0) {
      float l = lrun[qg];
      l += shfl16(l); l += shfl32(l);
      scale = 1.f / l;
    }
#pragma unroll
    for (int dt = 0; dt < 4; ++dt) {
      uint2 gu = *(const uint2*)(gbase + (size_t)t * INC + dt * 16 + fq * 4);
      float g0 = bflo(gu.x), g1 = bfhi(gu.x), g2 = bflo(gu.y), g3 = bfhi(gu.y);
      float r0 = o[qg][dt][0] * scale * g0 * __builtin_amdgcn_rcpf(1.f + __builtin_amdgcn_exp2f(-1.4426950408889634f * g0));
      float r1 = o[qg][dt][1] * scale * g1 * __builtin_amdgcn_rcpf(1.f + __builtin_amdgcn_exp2f(-1.4426950408889634f * g1));
      float r2 = o[qg][dt][2] * scale * g2 * __builtin_amdgcn_rcpf(1.f + __builtin_amdgcn_exp2f(-1.4426950408889634f * g2));
      float r3 = o[qg][dt][3] * scale * g3 * __builtin_amdgcn_rcpf(1.f + __builtin_amdgcn_exp2f(-1.4426950408889634f * g3));
      uint2 ou; ou.x = pack2(r0, r1); ou.y = pack2(r2, r3);
      *(uint2*)(obase + (size_t)t * 1024 + dt * 16 + fq * 4) = ou;
    }
  }
}

using f32x16 = __attribute__((ext_vector_type(16))) float;
template <int KIND>
DI void attn_item32(const Params& p, int layer, int item, char* smem, int g_tid, unsigned* qctr, int* s_item) {
  const int tid = g_tid, lane = tid & 63, wid = tid >> 6, q = lane & 31, hh = lane >> 5;
  bf16_t* Ksb[2]; bf16_t* Vsb[2];
  Ksb[0] = (bf16_t*)smem; Vsb[0] = Ksb[0] + 64 * AT_STR; Ksb[1] = Vsb[0] + 64 * AT_STR; Vsb[1] = Ksb[1] + 64 * AT_STR;
  unsigned* sU = (unsigned*)(smem + 4 * 64 * AT_STR * 2);
  int b, h, qt;
  const bf16_t *qbase, *gbase; bf16_t* obase; TileSrc ts;
  if (KIND == 0) {
    qt = 15 - (item & 15); int bh = item >> 4; h = bh % 6; b = bh / 6;
    const bf16_t* pb = p.proj + (size_t)(b * T) * INC;
    qbase = pb + C_SBQ + h * 64; gbase = pb + C_SBG + h * 64; ts.k = pb + C_SBK + h * 64; ts.kstride = INC;
    ts.v = pb + C_SBV + h * 64;
    obase = p.mixed + (size_t)(b * T) * 1024 + h * 64;
  } else if (KIND == 1) {
    qt = 15 - (item & 15); int bh = item >> 4; h = bh % 6; b = bh / 6;
    const bf16_t* pb = p.proj + (size_t)(b * T) * INC;
    qbase = pb + C_MBQ + h * 64; gbase = pb + C_MBG + h * 64; ts.k = pb + C_MBK + h * 64; ts.kstride = INC;
    ts.v = pb + C_MBV + h * 64;
    obase = p.mixed + (size_t)(b * T) * 1024 + 384 + h * 64;
  } else {
    qt = item & 15; int bh = item >> 4; h = bh & 3; b = bh >> 2;
    const bf16_t* pb = p.proj + (size_t)(b * T) * INC;
    qbase = pb + C_MQ + h * 64; gbase = pb + C_MG + h * 64;
    ts.k = p.mkv + (size_t)layer * NMEM * 512 + (size_t)(b * MEML) * 512 + h * 64; ts.kstride = 512;
    ts.v = ts.k + 256;
    obase = p.mixed + (size_t)(b * T) * 1024 + 768 + h * 64;
  }
  const int q0 = qt * 128;
  const int tmin = q0 + wid * 32, tmax = tmin + 31;
  const int t = tmin + q;
  bf16x8 qf[4];
#pragma unroll
  for (int ks = 0; ks < 4; ++ks) qf[ks] = *(const bf16x8*)(qbase + (size_t)t * INC + ks * 16 + hh * 8);
  uint2 gpre[2][4];
#pragma unroll
  for (int dt2 = 0; dt2 < 2; ++dt2)
#pragma unroll
    for (int g4 = 0; g4 < 4; ++g4) gpre[dt2][g4] = *(const uint2*)(gbase + (size_t)t * INC + dt2 * 32 + 8 * g4 + 4 * hh);
  const int own = q0 >> 8, own_start = own << 8;
  u32x4 rk[2], rv[2], rk2[2], rv2[2];
  tile_gload(ts, KIND == 0 ? ((q0 >> 6) + 1) * 64 : (KIND == 1 ? own_start : 0), tid, rk, rv);
  int ntile; unsigned U = 0; int n_own = 0; unsigned sel = 0u;
  if (KIND == 0) ntile = (q0 >> 6) + 2;
  else if (KIND == 2) ntile = 4;
  else {
    n_own = ((q0 - own_start) >> 6) + 2;
    if (own <= 3) { U = (1u << own) - 1u; sel = U; }
    else {
      f32x16 ga;
#pragma unroll
      for (int i = 0; i < 16; ++i) ga[i] = 0.f;
#pragma unroll
      for (int ks = 0; ks < 4; ++ks) {
        const float* kmp = p.kmean + (size_t)((layer * 8 + b) * 8 + (q & 7)) * 384 + h * 64 + ks * 16 + hh * 8;
        float4 k0v = *(const float4*)kmp, k1v = *(const float4*)(kmp + 4);
        float kmv[8] = {k0v.x, k0v.y, k0v.z, k0v.w, k1v.x, k1v.y, k1v.z, k1v.w};
        u32x4 hi, lo;
#pragma unroll
        for (int e = 0; e < 4; ++e) {
          float x0 = (q < 8) ? kmv[2 * e] : 0.f, x1 = (q < 8) ? kmv[2 * e + 1] : 0.f;
          bf16_t h0 = f2bf(x0), h1 = f2bf(x1);
          hi[e] = (unsigned)h0 | ((unsigned)h1 << 16);
          lo[e] = pack2(x0 - bf2f(h0), x1 - bf2f(h1));
        }
        ga = __builtin_amdgcn_mfma_f32_32x32x16_bf16(__builtin_bit_cast(bf16x8, hi), qf[ks], ga, 0, 0, 0);
        ga = __builtin_amdgcn_mfma_f32_32x32x16_bf16(__builtin_bit_cast(bf16x8, lo), qf[ks], ga, 0, 0, 0);
      }
      float gate[8];
#pragma unroll
      for (int j = 0; j < 4; ++j) {
        const float mine = ga[j], oth = shfl32(mine);
        gate[j] = hh ? oth : mine;
        gate[4 + j] = hh ? mine : oth;
      }
      unsigned sl = 0;
#pragma unroll
      for (int r = 0; r < 3; ++r) {
        float best = -3.0e38f; int bi = 0;
#pragma unroll
        for (int j = 0; j < 8; ++j) {
          bool ok = (j < own) && !((sl >> j) & 1u) && (gate[j] > best);
          best = ok ? gate[j] : best; bi = ok ? j : bi;
        }
        sl |= 1u << bi;
      }
      sel = sl;
      unsigned u = sel;
#pragma unroll
      for (int o = 32; o >= 1; o >>= 1) u |= __shfl_xor(u, o);
      __syncthreads();
      if (tid == 0) *sU = 0u;
      __syncthreads();
      if (lane == 0) atomicOr(sU, u);
      __syncthreads();
      U = *sU;
    }
    ntile = n_own + 4 * __popc(U);
  }
  auto tile_k0 = [&](int i) -> int {
    if (KIND == 0) return (ntile - 1 - i) * 64;
    if (KIND == 2) return i * 64;
    if (i < n_own) return own_start + i * 64;
    int ii = i - n_own, nb = ii >> 2, blk = 0; unsigned u = U;
    for (int c = 0; c < nb; ++c) u &= u - 1;
    blk = __ffs(u) - 1;
    return blk * 256 + (ii & 3) * 64;
  };
  f32x16 o[2];
#pragma unroll
  for (int dt2 = 0; dt2 < 2; ++dt2)
#pragma unroll
    for (int i = 0; i < 16; ++i) o[dt2][i] = 0.f;
  float mrun = -1e30f, lrun = 0.f;
  float carry = 1.f;
  const int qa = (q >> 2) & 1, qb = q >> 3, qc = q & 3;
  const int krow0 = (qb & 1) * 16 + (2 * qa + (qb >> 1)) * 4 + qc;
  const int vq4 = (lane & 15) >> 2, vp4 = lane & 3, vblk = (lane >> 4) & 1;

  __syncthreads();
  tile_sstore(Ksb[0], Vsb[0], tid, rk, rv);
  if (ntile > 1) tile_gload(ts, tile_k0(1), tid, rk, rv);
  __syncthreads();
  auto step = [&](const int i, u32x4 (&lk)[2], u32x4 (&lv)[2], const u32x4 (&sk)[2], const u32x4 (&sv2)[2]) -> bool {
    const int k0 = tile_k0(i);
    const bf16_t* Ks = Ksb[i & 1]; const bf16_t* Vs = Vsb[i & 1];
    if (i + 2 < ntile) tile_gload(ts, tile_k0(i + 2), tid, lk, lv);
    bool skip = false, diag = false;
    if (KIND == 0) { skip = (k0 >= tmax); diag = (k0 + 63 >= tmin); }
    if (KIND == 1 && i < n_own) { skip = (k0 > tmax); diag = (k0 + 63 > tmin); }
    if (!skip) {
      f32x16 s[2];
      float om[2][16];
#pragma unroll
      for (int kt2 = 0; kt2 < 2; ++kt2) {
        f32x16 z;
#pragma unroll
        for (int e = 0; e < 16; ++e) z[e] = 0.f;
#pragma unroll
        for (int ks = 0; ks < 4; ++ks) {
          const bf16x8 a = *(const bf16x8*)(Ks + (kt2 * 32 + krow0) * AT_STR + ks * 16 + hh * 8);
          z = __builtin_amdgcn_mfma_f32_32x32x16_bf16(a, qf[ks], z, 0, 0, 0);
        }
        s[kt2] = z;
      }
      if (KIND == 0) {
#pragma unroll
        for (int kt2 = 0; kt2 < 2; ++kt2)
#pragma unroll
          for (int e = 0; e < 16; ++e) {
            const float z2 = fmaxf(s[kt2][e] * C2, -100.f);
            const float ex = __builtin_amdgcn_exp2f(-z2);
            const float r = __builtin_amdgcn_rcpf(1.f + ex);
            s[kt2][e] = r; om[kt2][e] = ex * r;
          }
        if (diag) {
          asm volatile("" ::: "memory");
#pragma unroll
          for (int kt2 = 0; kt2 < 2; ++kt2)
#pragma unroll
            for (int e = 0; e < 16; ++e) {
              const bool act = (k0 + kt2 * 32 + 16 * hh + e) < t;
              s[kt2][e] = act ? s[kt2][e] : 0.f; om[kt2][e] = act ? om[kt2][e] : 1.f;
            }
        }
        float cp0 = om[0][0], cp1 = om[1][0];
#pragma unroll
        for (int e = 1; e < 16; ++e) { cp0 *= om[0][e]; cp1 *= om[1][e]; }
        const float oc0 = shfl32(cp0), oc1 = shfl32(cp1);
        const float tot0 = cp0 * oc0, tot1 = cp1 * oc1;
        float P = carry * (hh ? 1.f : oc1);
#pragma unroll
        for (int e = 15; e >= 0; --e) { const float w = s[1][e] * P; P *= om[1][e]; s[1][e] = w; }
        P = carry * tot1 * (hh ? 1.f : oc0);
#pragma unroll
        for (int e = 15; e >= 0; --e) { const float w = s[0][e] * P; P *= om[0][e]; s[0][e] = w; }
        carry *= tot0 * tot1;
      } else {
      bool lanevalid = true;
      if (KIND == 1 && i >= n_own) lanevalid = (sel >> (k0 >> 8)) & 1u;
      if (KIND == 1 && diag) {
        asm volatile("" ::: "memory");
#pragma unroll
        for (int kt2 = 0; kt2 < 2; ++kt2)
#pragma unroll
          for (int e = 0; e < 16; ++e) {
            const int key = k0 + kt2 * 32 + 16 * hh + e;
            s[kt2][e] = (key <= t) ? s[kt2][e] : -3.0e38f;
          }
      }
      float mx = -3.0e38f;
#pragma unroll
      for (int kt2 = 0; kt2 < 2; ++kt2)
#pragma unroll
        for (int e = 0; e < 16; ++e) mx = fmaxf(mx, s[kt2][e]);
      mx = lanevalid ? mx : -3.0e38f;
      mx = fmaxf(mx, shfl32(mx));
      const float mnew = fmaxf(mrun, mx * C2);
      const float alpha = __builtin_amdgcn_exp2f(mrun - mnew);
      mrun = mnew;
      const float c2e = lanevalid ? C2 : 0.f, nb = lanevalid ? -mnew : -1e30f;
      float ps = 0.f;
#pragma unroll
      for (int kt2 = 0; kt2 < 2; ++kt2)
#pragma unroll
        for (int e = 0; e < 16; ++e) { s[kt2][e] = __builtin_amdgcn_exp2f(__builtin_fmaf(s[kt2][e], c2e, nb)); ps += s[kt2][e]; }
      lrun = lrun * alpha + ps;
      if (__any(alpha != 1.f)) {
#pragma unroll
        for (int dt2 = 0; dt2 < 2; ++dt2) o[dt2] *= alpha;
      }
      }
      bf16x8 pw[2][2];
#pragma unroll
      for (int kt2 = 0; kt2 < 2; ++kt2)
#pragma unroll
        for (int s2 = 0; s2 < 2; ++s2) {
          f32x4 w0 = {s[kt2][8 * s2 + 0], s[kt2][8 * s2 + 1], s[kt2][8 * s2 + 2], s[kt2][8 * s2 + 3]};
          f32x4 w1 = {s[kt2][8 * s2 + 4], s[kt2][8 * s2 + 5], s[kt2][8 * s2 + 6], s[kt2][8 * s2 + 7]};
          pw[kt2][s2] = pack8(w0, w1);
        }
#pragma unroll
      for (int dt2 = 0; dt2 < 2; ++dt2)
#pragma unroll
        for (int kt2 = 0; kt2 < 2; ++kt2)
#pragma unroll
          for (int s2 = 0; s2 < 2; ++s2) {
            const bf16_t* vp = Vs + (kt2 * 32 + 16 * hh + 8 * s2 + vq4) * AT_STR + dt2 * 32 + vblk * 16 + 4 * vp4;
            s16x4_t lo = __builtin_amdgcn_ds_read_tr16_b64_v4i16((__attribute__((address_space(3))) s16x4_t*)(vp));
            s16x4_t hi = __builtin_amdgcn_ds_read_tr16_b64_v4i16((__attribute__((address_space(3))) s16x4_t*)(vp + 4 * AT_STR));
            bf16x8 a = __builtin_shufflevector(lo, hi, 0, 1, 2, 3, 4, 5, 6, 7);
            o[dt2] = __builtin_amdgcn_mfma_f32_32x32x16_bf16(a, pw[kt2][s2], o[dt2], 0, 0, 0);
          }
    }
    if (i + 1 < ntile) tile_sstore(Ksb[(i + 1) & 1], Vsb[(i + 1) & 1], tid, sk, sv2);
    if (KIND == 0) {
      if (!__syncthreads_or(carry >= 1.17549435e-38f)) return true;
    } else {
      __syncthreads();
    }
    return false;
  };
#pragma unroll 1
  for (int i = 0; i < ntile; i += 2) {
    if (step(i, rk2, rv2, rk, rv)) break;
    if (i + 1 < ntile) { if (step(i + 1, rk, rv, rk2, rv2)) break; }
  }
  unsigned nxt_item = 0u;
  if (tid == 0) nxt_item = gridDim.x + atomicAdd(qctr, 1u);
  {
    float l = lrun;
    l += shfl32(l);
    const float scale = (KIND == 0) ? 1.f : __builtin_amdgcn_rcpf(l);
#pragma unroll
    for (int dt2 = 0; dt2 < 2; ++dt2)
#pragma unroll
      for (int g4 = 0; g4 < 4; ++g4) {
        const int d0 = dt2 * 32 + 8 * g4 + 4 * hh;
        const uint2 gu = gpre[dt2][g4];
        const float gg[4] = {bflo(gu.x), bfhi(gu.x), bflo(gu.y), bfhi(gu.y)};
        float r[4];
#pragma unroll
        for (int j = 0; j < 4; ++j)
          r[j] = o[dt2][g4 * 4 + j] * scale * gg[j] * __builtin_amdgcn_rcpf(1.f + __builtin_amdgcn_exp2f(-1.4426950408889634f * gg[j]));
        uint2 ou; ou.x = pack2(r[0], r[1]); ou.y = pack2(r[2], r[3]);
        *(uint2*)(obase + (size_t)t * 1024 + d0) = ou;
      }
  }
  if (tid == 0) *s_item = (int)nxt_item;
}

DI void phase_attn(const Params& p, int layer, char* smem, int g_tid, int g_bid) {
  int* s_item = (int*)(smem + 4 * 64 * AT_STR * 2 + 16);
  unsigned* qctr = p.bar + 3456 + layer * 16;
  __syncthreads();
  if (g_tid == 0) *s_item = g_bid;
  for (;;) {
    __syncthreads();
    const int it = *s_item;
    if (it >= 2048) break;
    if (it < 768) { int qrank = it / 48, bh = it % 48; attn_item32<1>(p, layer, bh * 16 + qrank, smem, g_tid, qctr, s_item); }
    else if (it < 1536) { int u = it - 768; int qrank = u / 48, bh = u % 48; attn_item32<0>(p, layer, bh * 16 + qrank, smem, g_tid, qctr, s_item); }
    else attn_item32<2>(p, layer, it - 1536, smem, g_tid, qctr, s_item);
  }
}

DI void phase_final(const Params& p, int g_tid, int g_bid) {
  const int lane = g_tid & 63, wid = g_tid >> 6;
  const int stride = gridDim.x * 4;
  float4 g[2][2];
#pragma unroll
  for (int i = 0; i < 2; ++i) { g[i][0] = *(const float4*)(p.final_g + i * 512 + lane * 8); g[i][1] = *(const float4*)(p.final_g + i * 512 + lane * 8 + 4); }
  for (int r0 = g_bid * 4 + wid; r0 < NTOK; r0 += 4 * stride) {
    uint4 v[4][2]; float ssv[4];
#pragma unroll
    for (int u = 0; u < 4; ++u) {
      const int r = r0 + u * stride;
      if (r < NTOK) {
        ssv[u] = p.ss[2 * NTOK + r];
#pragma unroll
        for (int i = 0; i < 2; ++i) v[u][i] = *(const uint4*)(p.xb + (size_t)r * 1024 + i * 512 + lane * 8);
      }
    }
#pragma unroll
    for (int u = 0; u < 4; ++u) {
      const int r = r0 + u * stride;
      if (r < NTOK) {
        const float rs = rsqrtf(ssv[u] * (1.f / 1024.f) + 1e-6f);
#pragma unroll
        for (int i = 0; i < 2; ++i) {
          const uint4 w = v[u][i];
          float4 o0, o1;
          o0.x = bflo(w.x) * rs * g[i][0].x; o0.y = bfhi(w.x) * rs * g[i][0].y; o0.z = bflo(w.y) * rs * g[i][0].z; o0.w = bfhi(w.y) * rs * g[i][0].w;
          o1.x = bflo(w.z) * rs * g[i][1].x; o1.y = bfhi(w.z) * rs * g[i][1].y; o1.z = bflo(w.w) * rs * g[i][1].z; o1.w = bfhi(w.w) * rs * g[i][1].w;
          *(float4*)(p.out + (size_t)r * 1024 + i * 512 + lane * 8) = o0;
          *(float4*)(p.out + (size_t)r * 1024 + i * 512 + lane * 8 + 4) = o1;
        }
      }
    }
  }
}

#define XB_TMO      128
#define XB_XCNT(j)  (256  + 64 * (j))
#define XB_XSUB(j)  (1280 + 64 * (j))
#define XB_XGEN(j)  (2304 + 64 * (j))
#define XB_TOP      3328
#define XB_TOPGEN   3392
#define XCD_BAR_WORDS 3456
#define XB_SPIN_CAP (1u << 18)
#define LAS __attribute__((address_space(3)))
DI unsigned xb_ld(unsigned* p) { return __hip_atomic_load(p, __ATOMIC_RELAXED, __HIP_MEMORY_SCOPE_AGENT); }
DI unsigned xb_add(unsigned* p, unsigned v) { return __hip_atomic_fetch_add(p, v, __ATOMIC_RELAXED, __HIP_MEMORY_SCOPE_AGENT); }
DI unsigned xb_xcc_id() { return (unsigned)__builtin_amdgcn_s_getreg((3 << 11) | 20) & 0xFu; }
#define XB_SPIN(cond, bar) do { unsigned _sp = 0; while (cond) { __builtin_amdgcn_s_sleep(1); \
    if ((++_sp & 255u) == 0u) { if (xb_ld(&(bar)[XB_TMO])) break; if (_sp > XB_SPIN_CAP) { atomicAdd(&(bar)[XB_TMO], 1u); break; } } } } while (0)
struct XcdBarrier { unsigned* bar; unsigned x; volatile LAS unsigned* st; };
DI XcdBarrier xcd_barrier_post(unsigned* bar, volatile LAS unsigned* st) {
  XcdBarrier b; b.bar = bar; b.x = xb_xcc_id(); b.st = st;
  if (threadIdx.x == 0) (void)xb_add(&bar[XB_XCNT(b.x)], 1u);
  return b;
}
DI void xcd_barrier_complete(unsigned* bar, unsigned x, unsigned& nloc, unsigned& nx) {
  const unsigned G = gridDim.x * gridDim.y * gridDim.z;
  unsigned sum, cnt, mine, sp = 0u;
  for (;;) {
    sum = 0u; cnt = 0u; mine = 0u;
#pragma unroll
    for (unsigned j = 0; j < 16; ++j) { const unsigned c = xb_ld(&bar[XB_XCNT(j)]); sum += c; cnt += (c > 0u) ? 1u : 0u; mine = (j == x) ? c : mine; }
    if (sum == G) break;
    __builtin_amdgcn_s_sleep(1);
    if ((++sp & 255u) == 0u) { if (xb_ld(&bar[XB_TMO])) break; if (sp > XB_SPIN_CAP) { atomicAdd(&bar[XB_TMO], 1u); break; } }
  }
  nloc = mine > 0u ? mine : 1u; nx = cnt > 0u ? cnt : 1u;
}
DI void xcd_barrier(const XcdBarrier& b) {
  asm volatile("s_waitcnt vmcnt(0)" ::: "memory");
  __syncthreads();
  if (threadIdx.x == 0) {
    unsigned* bar = b.bar;
    __builtin_amdgcn_s_waitcnt(0);
    unsigned nloc = b.st[0], nx = b.st[1];
    if (nloc == 0u) { xcd_barrier_complete(bar, b.x, nloc, nx); b.st[0] = nloc; b.st[1] = nx; }
    const unsigned old = xb_add(&bar[XB_XSUB(b.x)], 1u);
    const unsigned gen = old / nloc;
    if (old + 1u == (gen + 1u) * nloc) {
      __builtin_amdgcn_fence(__ATOMIC_RELEASE, "agent");
      asm volatile("s_waitcnt vmcnt(0)" ::: "memory");
      const unsigned og = xb_add(&bar[XB_TOP], 1u);
      const unsigned tg = og / nx;
      if (og + 1u == (tg + 1u) * nx) xb_add(&bar[XB_TOPGEN], 1u);
      else XB_SPIN(xb_ld(&bar[XB_TOPGEN]) == tg, bar);
      __builtin_amdgcn_fence(__ATOMIC_ACQUIRE, "agent");
      xb_add(&bar[XB_XGEN(b.x)], 1u);
      asm volatile("s_waitcnt vmcnt(0)" ::: "memory");
    } else {
      XB_SPIN(xb_ld(&bar[XB_XGEN(b.x)]) == gen, bar);
      __builtin_amdgcn_fence(__ATOMIC_ACQUIRE, "agent");
      asm volatile("s_waitcnt vmcnt(0)" ::: "memory");
    }
  }
  __syncthreads();
}

constexpr int NPHASE = 8;
#define PHASE_BEGIN(n) if (ph_lo <= (n) && (n) < ph_hi) { int g_tid = threadIdx.x, g_bid = blockIdx.x; asm volatile("" : "+v"(g_tid)); asm volatile("" : "+s"(g_bid));
#define PHASE_END(n) if ((n) + 1 < ph_hi) xcd_barrier(xb); }
__global__ void __launch_bounds__(256, 2) mega(Params p, int ph_lo, int ph_hi) {
  __shared__ __attribute__((aligned(16))) char smem[3 * G_STAGE + 64];
  __shared__ uint4 xb_words;
  cg::grid_group grid = cg::this_grid();
  if (ph_hi < 0) grid.sync();
  if (threadIdx.x == 0) xb_words = make_uint4(0u, 0u, 0u, 0u);
  __syncthreads();
  XcdBarrier xb = xcd_barrier_post(p.bar, (volatile LAS unsigned*)&xb_words);
  PHASE_BEGIN(0) phase_prepass(p, smem, g_tid, g_bid); PHASE_END(0)
  PHASE_BEGIN(1)
    {
      const int xcd = g_bid & 7, loc = g_bid >> 3, nloc = gridDim.x >> 3;
      const int nr1 = (272 + nloc - 1) / nloc; const bool stag = loc >= (nloc >> 1);
      for (int r = 0; r < nr1; ++r) {
        const int rr = stag ? (r + 3) % nr1 : r;
        const int j = loc + rr * nloc;
        if (j >= 272) continue;
        if (j < 192) gemm_tile<0, 8>(p, 0, xcd * 8 + (j & 7), j >> 3, smem, g_tid);
        else if (j < 256) { int jj = 192 + ((j - 192) >> 1), hf = j & 1; gemm_tile<0, 4>(p, 0, (xcd * 8 + (jj & 7)) * 2 + hf, jj >> 3, smem, g_tid); }
        else { int u = xcd * 16 + (j - 256); int layer = u >> 6, r = u & 63; gemm_tile<1, 4>(p, layer, r >> 2, r & 3, smem, g_tid); }
      }
    }
  PHASE_END(1)
  PHASE_BEGIN(2) phase_attn(p, 0, smem, g_tid, g_bid); PHASE_END(2)
  PHASE_BEGIN(3)
    {
      const int xcd = g_bid & 7, loc = g_bid >> 3, nloc = gridDim.x >> 3;
      for (int j = loc; j < 64; j += nloc) gemm_tile<2, 8>(p, 0, xcd * 8 + (j & 7), j >> 3, smem, g_tid);
    }
  PHASE_END(3)
  PHASE_BEGIN(4)
    {
      const int xcd = g_bid & 7, loc = g_bid >> 3, nloc = gridDim.x >> 3;
      const int nr4 = (256 + nloc - 1) / nloc; const bool stag = loc >= (nloc >> 1);
      for (int r = 0; r < nr4; ++r) {
        const int rr = stag ? (r + nr4 - 1) % nr4 : r;
        const int j = loc + rr * nloc;
        if (j >= 256) continue;
        if (j < 192) gemm_tile<0, 8>(p, 1, xcd * 8 + (j & 7), j >> 3, smem, g_tid);
        else { int jj = 192 + ((j - 192) >> 1), hf = j & 1; gemm_tile<0, 4>(p, 1, (xcd * 8 + (jj & 7)) * 2 + hf, jj >> 3, smem, g_tid); }
      }
    }
  PHASE_END(4)
  PHASE_BEGIN(5) phase_attn(p, 1, smem, g_tid, g_bid); PHASE_END(5)
  PHASE_BEGIN(6)
    {
      const int xcd = g_bid & 7, loc = g_bid >> 3, nloc = gridDim.x >> 3;
      for (int j = loc; j < 64; j += nloc) gemm_tile<2, 8>(p, 1, xcd * 8 + (j & 7), j >> 3, smem, g_tid);
    }
  PHASE_END(6)
  PHASE_BEGIN(7) phase_final(p, g_tid, g_bid); PHASE_END(7)
}

extern "C" void kernel_launch(void* const* d_in, const int* in_sizes, int n_in, void* d_out, int out_size, void* d_ws, size_t ws_size,
                              hipStream_t stream) {
  Params p{};
  p.x = (const float*)d_in[0]; p.mem = (const float*)d_in[1]; p.norm_g = (const float*)d_in[2]; p.w_in = (const float*)d_in[3];
  p.mem_norm_g = (const float*)d_in[4]; p.w_mem_kv = (const float*)d_in[5]; p.w_out = (const float*)d_in[6];
  p.final_g = (const float*)d_in[7];
  p.out = (float*)d_out;
  char* ws = (char*)d_ws;
  p.xb = (bf16_t*)(ws + 0);
  p.proj = (bf16_t*)(ws + 33554432ull);
  p.mixed = (bf16_t*)(ws + 150994944ull);
  p.wTin = (bf16_t*)(ws + 184549376ull);
  p.wTkv = (bf16_t*)(ws + 199229440ull);
  p.wTout = (bf16_t*)(ws + 201326592ull);
  p.memb = (bf16_t*)(ws + 205520896ull);
  p.mkv = (bf16_t*)(ws + 209715200ull);
  p.ss = (float*)(ws + 213909504ull);
  p.memss = (float*)(ws + 214106112ull);
  p.kmean = (float*)(ws + 214114304ull);
  p.costab = (float*)(ws + 214310912ull);
  p.sintab = (float*)(ws + 214376448ull);
  p.sbvT = (bf16_t*)(ws + 214441984ull);
  p.mbvT = (bf16_t*)(ws + 227024896ull);
  p.mvT = (bf16_t*)(ws + 239607808ull);
  p.bar = (unsigned*)(ws + 241704960ull);

  static int grid_blocks = 0;
  if (!grid_blocks) {
    int dev = 0, cus = 0, per_cu = 0;
    (void)hipGetDevice(&dev);
    (void)hipDeviceGetAttribute(&cus, hipDeviceAttributeMultiprocessorCount, dev);
    (void)hipOccupancyMaxActiveBlocksPerMultiprocessor(&per_cu, mega, 256, 0);
    if (per_cu > 2) per_cu = 2;
    if (per_cu < 1) per_cu = 1;
    grid_blocks = cus * per_cu;
  }
#if MULTI_LAUNCH
  for (int ph = 0; ph < NPHASE; ++ph) {
    if (NAIVE_ATTN && (ph == 2 || ph == 5)) {
      int layer = ph == 2 ? 0 : 1;
      hipLaunchKernelGGL(attn_naive_sb, dim3(384), dim3(256), 0, stream, p, layer);
      hipLaunchKernelGGL(attn_naive_moba, dim3(384), dim3(256), 0, stream, p, layer);
      hipLaunchKernelGGL(attn_naive_mem, dim3(256), dim3(256), 0, stream, p, layer);
    } else {
      hipLaunchKernelGGL(mega, dim3(grid_blocks), dim3(256), 0, stream, p, ph, ph + 1);
    }
  }
#else
  int lo = 0, hi = NPHASE;
  (void)hipMemsetAsync(p.bar, 0, (XCD_BAR_WORDS + 64) * sizeof(unsigned), stream);
  void* args[] = {&p, &lo, &hi};
  hipError_t e = hipLaunchCooperativeKernel((void*)mega, dim3(grid_blocks), dim3(256), args, 0, stream);
  if (e != hipSuccess) fprintf(stderr, "cooperative launch failed: %s (grid %d)\n", hipGetErrorString(e), grid_blocks);
#endif
}
```
